# Optimizing an MI355X kernel written in HIP

```python
import numpy as np
import jax
import jax.numpy as jnp
from jax import lax

D_MODEL = 4096
BATCH = 4
SEQ = 4096
DEPTH = 1

HEAD_DIM = 128
N_HEADS = D_MODEL // HEAD_DIM
NSA_HEADS = N_HEADS // 2
MLA_HEADS = N_HEADS - NSA_HEADS
NSA_KV_GROUPS = 4
NSA_Q_PER_KV = NSA_HEADS // NSA_KV_GROUPS
CMP_LEN = 32
CMP_STRIDE = 16
CMP_HIDDEN = 256
SEL_LEN = 64
N_SEL = 16
N_LOCAL_FORCED = 2
FORCED_BONUS = 1e4
WINDOW = 512
MLA_Q_RANK = 1536
MLA_KV_RANK = 512
MLA_NOPE = 128
MLA_ROPE = 64
MLA_V = 128
ROPE_THETA = 500000.0
PARTIAL_ROT = HEAD_DIM // 4
D_FF = 4 * D_MODEL
ALPHA = (2 * DEPTH) ** 0.25
BETA = (8 * DEPTH) ** -0.25
SEL_Q_BLOCK = 32
DENSE_Q_BLOCK = 128
NEG = -1e30
N_ADA = 6
NSA_KV_WIDTH = NSA_KV_GROUPS * HEAD_DIM
IN_SPLITS = (NSA_HEADS * HEAD_DIM, 6 * NSA_KV_WIDTH, NSA_HEADS * 3, MLA_Q_RANK, MLA_KV_RANK, MLA_ROPE)
D_IN = sum(IN_SPLITS)
D_MIX_OUT = NSA_HEADS * HEAD_DIM + MLA_HEADS * MLA_V

kernel_name = 'hybrid_nsa_mla_deepnorm_adaln_block'


def _layernorm(x, g, b, eps=1e-5):
    xf = x.astype(jnp.float32)
    mu = jnp.mean(xf, axis=-1, keepdims=True)
    var = jnp.mean(jnp.square(xf - mu), axis=-1, keepdims=True)
    return ((xf - mu) * lax.rsqrt(var + eps) * g.astype(jnp.float32) + b.astype(jnp.float32)).astype(x.dtype)


def _rmsnorm(x, g, eps=1e-6):
    xf = x.astype(jnp.float32)
    y = xf * lax.rsqrt(jnp.mean(jnp.square(xf), axis=-1, keepdims=True) + eps)
    return (y * g.astype(jnp.float32)).astype(x.dtype)


def _rope_tables(positions, rot_dim):
    inv = jnp.power(ROPE_THETA, -jnp.arange(0, rot_dim, 2, dtype=jnp.float32) / rot_dim)
    ang = positions.astype(jnp.float32)[..., None] * inv
    return jnp.cos(ang)[:, :, None, :], jnp.sin(ang)[:, :, None, :]


def _apply_rope(x, cos, sin):
    half = cos.shape[-1]
    rot = 2 * half
    cos = cos.astype(x.dtype)
    sin = sin.astype(x.dtype)
    x1, x2, rest = x[..., :half], x[..., half:rot], x[..., rot:]
    return jnp.concatenate([x1 * cos - x2 * sin, x2 * cos + x1 * sin, rest], axis=-1)


def _nsa(q, k_cmp, v_cmp, k_sel, v_sel, k_win, v_win, gates, pos_k, pos_v, w_k1, w_k2, w_v1, w_v2):
    B, S = q.shape[0], q.shape[1]
    G, R, Dh = NSA_KV_GROUPS, NSA_Q_PER_KV, HEAD_DIM
    scale = Dh ** -0.5
    qg = q.reshape(B, S, G, R, Dh)
    t = jnp.arange(S)

    ncmp = (S - CMP_LEN) // CMP_STRIDE + 1
    blk = np.arange(ncmp)[:, None] * CMP_STRIDE + np.arange(CMP_LEN)[None, :]

    def compress(kv, pos, w1, w2):
        blocks = kv[:, blk] + pos[:, None, :]
        flat = blocks.transpose(0, 3, 1, 2, 4).reshape(B, G, ncmp, CMP_LEN * Dh)
        return jax.nn.gelu(flat @ w1) @ w2

    kc = compress(k_cmp, pos_k, w_k1, w_k2)
    vc = compress(v_cmp, pos_v, w_v1, w_v2)
    cmp_end = np.arange(ncmp) * CMP_STRIDE + CMP_LEN - 1
    mask_cmp = cmp_end[None, :] <= t[:, None]
    s_cmp = jnp.einsum('bsgrd,bgnd->bgrsn', qg, kc).astype(jnp.float32) * scale
    p_cmp = jax.nn.softmax(jnp.where(mask_cmp, s_cmp, NEG), axis=-1) * mask_cmp
    o_cmp = jnp.einsum('bgrsn,bgnd->bsgrd', p_cmp.astype(vc.dtype), vc)

    nb = S // SEL_LEN
    n_sel = min(N_SEL, nb)
    c_start = np.arange(ncmp) * CMP_STRIDE
    b_start = np.arange(nb) * SEL_LEN
    overlap = ((c_start[:, None] < b_start[None, :] + SEL_LEN) &
               (c_start[:, None] + CMP_LEN > b_start[None, :])).astype(np.float32)
    imp = jnp.einsum('bgrsn,nj->bgsj', p_cmp, jnp.asarray(overlap))
    cur = (t // SEL_LEN)[:, None]
    j = jnp.arange(nb)[None, :]
    forced = (j == 0) | ((j <= cur) & (j > cur - N_LOCAL_FORCED))
    imp = jnp.where(j > cur, NEG, imp + jnp.where(forced, FORCED_BONUS, 0.0))
    _, sel_idx = lax.top_k(imp, n_sel)

    QC = min(SEL_Q_BLOCK, S)
    nqc = S // QC
    k_sel_b = k_sel.transpose(0, 2, 1, 3).reshape(B, G, nb, SEL_LEN, Dh)
    v_sel_b = v_sel.transpose(0, 2, 1, 3).reshape(B, G, nb, SEL_LEN, Dh)
    pad = ((0, 0), (0, 0), (WINDOW, 0), (0, 0))
    k_win_p = jnp.pad(k_win.transpose(0, 2, 1, 3), pad)
    v_win_p = jnp.pad(v_win.transpose(0, 2, 1, 3), pad)
    q_chunks = qg.reshape(B, nqc, QC, G, R, Dh).transpose(1, 0, 2, 3, 4, 5)
    idx_chunks = sel_idx.reshape(B, G, nqc, QC, n_sel).transpose(2, 0, 1, 3, 4)
    gather_blocks = jax.vmap(jax.vmap(lambda kb, ix: kb[ix]))

    def chunk(args):
        qc, ic, ci = args
        start = ci * QC
        tq = start + jnp.arange(QC)
        ks = gather_blocks(k_sel_b, ic)
        vs = gather_blocks(v_sel_b, ic)
        kpos = ic[..., None] * SEL_LEN + jnp.arange(SEL_LEN)
        m_sel = (kpos <= tq[None, None, :, None, None]).reshape(B, G, 1, QC, n_sel * SEL_LEN)
        s_sel = jnp.einsum('bqgrd,bgqnld->bgrqnl', qc, ks).astype(jnp.float32) * scale
        s_sel = s_sel.reshape(B, G, R, QC, n_sel * SEL_LEN)
        p_sel = jax.nn.softmax(jnp.where(m_sel, s_sel, NEG), axis=-1).reshape(B, G, R, QC, n_sel, SEL_LEN)
        o_sel = jnp.einsum('bgrqnl,bgqnld->bqgrd', p_sel.astype(vs.dtype), vs)

        kw = lax.dynamic_slice_in_dim(k_win_p, start, WINDOW + QC, axis=2)
        vw = lax.dynamic_slice_in_dim(v_win_p, start, WINDOW + QC, axis=2)
        wpos = start - WINDOW + jnp.arange(WINDOW + QC)
        diff = tq[:, None] - wpos[None, :]
        m_win = (diff >= 0) & (diff < WINDOW) & (wpos[None, :] >= 0)
        s_win = jnp.einsum('bqgrd,bgkd->bgrqk', qc, kw).astype(jnp.float32) * scale
        p_win = jax.nn.softmax(jnp.where(m_win, s_win, NEG), axis=-1)
        o_win = jnp.einsum('bgrqk,bgkd->bqgrd', p_win.astype(vw.dtype), vw)
        return o_sel, o_win

    o_sel, o_win = lax.map(chunk, (q_chunks, idx_chunks, jnp.arange(nqc)))
    o_sel = o_sel.transpose(1, 0, 2, 3, 4, 5).reshape(B, S, G, R, Dh)
    o_win = o_win.transpose(1, 0, 2, 3, 4, 5).reshape(B, S, G, R, Dh)

    g = gates.reshape(B, S, G, R, 3)
    out = g[..., 0:1] * o_cmp + g[..., 1:2] * o_sel + g[..., 2:3] * o_win
    return out.reshape(B, S, NSA_HEADS * Dh)


def _causal_attention(q, k, v, scale):
    B, S, H, Dk = q.shape
    QB = min(DENSE_Q_BLOCK, S)
    nqb = S // QB
    q_blocks = q.reshape(B, nqb, QB, H, Dk).transpose(1, 0, 2, 3, 4)
    kpos = jnp.arange(S)

    def block(args):
        qb, bi = args
        tq = bi * QB + jnp.arange(QB)
        s = jnp.einsum('bqhd,bkhd->bhqk', qb, k).astype(jnp.float32) * scale
        p = jax.nn.softmax(jnp.where(kpos[None, :] <= tq[:, None], s, NEG), axis=-1)
        return jnp.einsum('bhqk,bkhd->bqhd', p.astype(v.dtype), v)

    o = lax.map(block, (q_blocks, jnp.arange(nqb)))
    return o.transpose(1, 0, 2, 3, 4).reshape(B, S, H * v.shape[-1])


def _mla(c_q, c_kv, k_rope, q_norm, kv_norm, w_uq, w_ukv, cos, sin):
    B, S = c_q.shape[0], c_q.shape[1]
    H = MLA_HEADS
    q = (_rmsnorm(c_q, q_norm) @ w_uq).reshape(B, S, H, MLA_NOPE + MLA_ROPE)
    q = jnp.concatenate([q[..., :MLA_NOPE], _apply_rope(q[..., MLA_NOPE:], cos, sin)], axis=-1)
    kv = (_rmsnorm(c_kv, kv_norm) @ w_ukv).reshape(B, S, H, MLA_NOPE + MLA_V)
    k_nope, v = kv[..., :MLA_NOPE], kv[..., MLA_NOPE:]
    k_pe = _apply_rope(k_rope[:, :, None, :], cos, sin)
    k = jnp.concatenate([k_nope, jnp.broadcast_to(k_pe, (B, S, H, MLA_ROPE))], axis=-1)
    return _causal_attention(q, k, v, (MLA_NOPE + MLA_ROPE) ** -0.5)


def _mixer(h, w_in, pos_k, pos_v, k1, k2, v1, v2, q_norm, kv_norm, w_uq, w_ukv, w_out,
           cos_p, sin_p, cos_m, sin_m):
    B, S = h.shape[0], h.shape[1]
    proj = h @ w_in
    q_nsa, kv_nsa, gate_logits, c_q, c_kv, k_rope = jnp.split(
        proj, np.cumsum(IN_SPLITS)[:-1].tolist(), axis=-1)
    q_nsa = _apply_rope(q_nsa.reshape(B, S, NSA_HEADS, HEAD_DIM), cos_p, sin_p)
    kv = kv_nsa.reshape(B, S, 6, NSA_KV_GROUPS, HEAD_DIM)
    k_cmp = _apply_rope(kv[:, :, 0], cos_p, sin_p)
    k_sel = _apply_rope(kv[:, :, 2], cos_p, sin_p)
    k_win = _apply_rope(kv[:, :, 4], cos_p, sin_p)
    gates = jax.nn.sigmoid(gate_logits).reshape(B, S, NSA_HEADS, 3)
    o_nsa = _nsa(q_nsa, k_cmp, kv[:, :, 1], k_sel, kv[:, :, 3], k_win, kv[:, :, 5], gates,
                 pos_k, pos_v, k1, k2, v1, v2)
    o_mla = _mla(c_q, c_kv, k_rope, q_norm, kv_norm, w_uq, w_ukv, cos_m, sin_m)
    return jnp.concatenate([o_nsa, o_mla], axis=-1) @ w_out


def setup_inputs(seed: int = 0) -> dict:
    key = jax.random.key(seed)
    ks = jax.random.split(key, 24)
    f32 = jnp.float32
    L = DEPTH

    def nrm(k, shape, scale):
        return jax.random.normal(k, shape, f32) * scale

    return {
        'x': nrm(ks[0], (BATCH, SEQ, D_MODEL), 1.0),
        'c': nrm(ks[1], (BATCH, D_MODEL), 1.0),
        'positions': jnp.tile(jnp.arange(SEQ, dtype=jnp.int32)[None, :], (BATCH, 1)),
        'w_ada': nrm(ks[2], (L, D_MODEL, N_ADA * D_MODEL), 0.5 * D_MODEL ** -0.5),
        'b_ada': nrm(ks[3], (L, N_ADA * D_MODEL), 0.02),
        'w_in': nrm(ks[4], (L, D_MODEL, D_IN), D_MODEL ** -0.5),
        'nsa_pos_k': nrm(ks[5], (L, CMP_LEN, HEAD_DIM), 0.1),
        'nsa_pos_v': nrm(ks[6], (L, CMP_LEN, HEAD_DIM), 0.1),
        'nsa_cmp_k1': nrm(ks[7], (L, CMP_LEN * HEAD_DIM, CMP_HIDDEN), (CMP_LEN * HEAD_DIM) ** -0.5),
        'nsa_cmp_k2': nrm(ks[8], (L, CMP_HIDDEN, HEAD_DIM), CMP_HIDDEN ** -0.5),
        'nsa_cmp_v1': nrm(ks[9], (L, CMP_LEN * HEAD_DIM, CMP_HIDDEN), (CMP_LEN * HEAD_DIM) ** -0.5),
        'nsa_cmp_v2': nrm(ks[10], (L, CMP_HIDDEN, HEAD_DIM), CMP_HIDDEN ** -0.5),
        'mla_q_norm': 1.0 + nrm(ks[11], (L, MLA_Q_RANK), 0.02),
        'mla_kv_norm': 1.0 + nrm(ks[12], (L, MLA_KV_RANK), 0.02),
        'mla_w_uq': nrm(ks[13], (L, MLA_Q_RANK, MLA_HEADS * (MLA_NOPE + MLA_ROPE)), MLA_Q_RANK ** -0.5),
        'mla_w_ukv': nrm(ks[14], (L, MLA_KV_RANK, MLA_HEADS * (MLA_NOPE + MLA_V)), MLA_KV_RANK ** -0.5),
        'w_out': nrm(ks[15], (L, D_MIX_OUT, D_MODEL), BETA * D_MIX_OUT ** -0.5),
        'ln1_g': 1.0 + nrm(ks[16], (L, D_MODEL), 0.02),
        'ln1_b': nrm(ks[17], (L, D_MODEL), 0.02),
        'w_ff1': nrm(ks[18], (L, D_MODEL, D_FF), D_MODEL ** -0.5),
        'w_ff2': nrm(ks[19], (L, D_FF, D_MODEL), BETA * D_FF ** -0.5),
        'ln2_g': 1.0 + nrm(ks[20], (L, D_MODEL), 0.02),
        'ln2_b': nrm(ks[21], (L, D_MODEL), 0.02),
    }


def reference(x, c, positions, w_ada, b_ada, w_in, nsa_pos_k, nsa_pos_v, nsa_cmp_k1, nsa_cmp_k2,
              nsa_cmp_v1, nsa_cmp_v2, mla_q_norm, mla_kv_norm, mla_w_uq, mla_w_ukv, w_out,
              ln1_g, ln1_b, w_ff1, w_ff2, ln2_g, ln2_b):
    cos_p, sin_p = _rope_tables(positions, PARTIAL_ROT)
    cos_m, sin_m = _rope_tables(positions, MLA_ROPE)
    cond = jax.nn.silu(c)
    for layer in range(DEPTH):
        mod = (cond @ w_ada[layer] + b_ada[layer])[:, None, :]
        sh_a, sc_a, g_a, sh_m, sc_m, g_m = jnp.split(mod, N_ADA, axis=-1)
        h = x * (1.0 + sc_a) + sh_a
        a = _mixer(h, w_in[layer], nsa_pos_k[layer], nsa_pos_v[layer], nsa_cmp_k1[layer],
                   nsa_cmp_k2[layer], nsa_cmp_v1[layer], nsa_cmp_v2[layer], mla_q_norm[layer],
                   mla_kv_norm[layer], mla_w_uq[layer], mla_w_ukv[layer], w_out[layer],
                   cos_p, sin_p, cos_m, sin_m)
        x = _layernorm(ALPHA * x + (1.0 + g_a) * a, ln1_g[layer], ln1_b[layer])
        h = x * (1.0 + sc_m) + sh_m
        f = jnp.square(jax.nn.relu(h @ w_ff1[layer])) @ w_ff2[layer]
        x = _layernorm(ALPHA * x + (1.0 + g_m) * f, ln2_g[layer], ln2_b[layer])
    return x
```

```cpp
#include <hip/hip_runtime.h>
#include <cstdio>
#include <cstdint>

#define LAS __attribute__((address_space(3)))
#define GAS __attribute__((address_space(1)))
typedef unsigned short bf16_t;
typedef short bf16x8 __attribute__((ext_vector_type(8)));
typedef short s16x4 __attribute__((ext_vector_type(4)));
typedef float f32x2 __attribute__((ext_vector_type(2)));
typedef float f32x4 __attribute__((ext_vector_type(4)));
typedef float f32x16 __attribute__((ext_vector_type(16)));
typedef unsigned u32x2 __attribute__((ext_vector_type(2)));
typedef unsigned u32x4 __attribute__((ext_vector_type(4)));
typedef __bf16 bf16x2_t __attribute__((ext_vector_type(2)));

#ifndef MK_N_LAUNCHES
#define MK_N_LAUNCHES 1
#endif
constexpr int NPHASE = 10;
#ifndef FP8_IN_
#define FP8_IN_ 1
#endif
#ifndef FP8_OUT_
#define FP8_OUT_ 1
#endif
#ifndef FP8_UP_
#define FP8_UP_ 1
#endif
constexpr bool FP8_UP = FP8_UP_ != 0;
constexpr bool FP8_IN = FP8_IN_ != 0, FP8_OUT = FP8_OUT_ != 0;
constexpr int N_LAUNCHES = MK_N_LAUNCHES;

constexpr int NB = 4, S = 4096, D = 4096, T = NB * S;
constexpr int DINP = 7424;
constexpr int DFF = 16384;
constexpr int NADA = 6 * D;
constexpr int QR = 1536, KVR = 512;
constexpr float ALPHA = 1.189207115002721f;
constexpr float LOG2E = 1.4426950408889634f;
constexpr int ADA_KCH = 16;

constexpr size_t MiB = 1u << 20;
constexpr size_t WS_CTL = 0, CTL_ZERO_BYTES = 1 * MiB;
constexpr size_t WS_MODP = 1 * MiB;
constexpr size_t WS_MODF = 7 * MiB;
constexpr size_t WS_ROPEP = 8 * MiB;
constexpr size_t WS_ROPEM = 10 * MiB;
constexpr size_t WS_SMALL = 14 * MiB;
constexpr size_t WS_K1T = 15 * MiB, WS_V1T = 17 * MiB;
constexpr size_t WS_WINT = 19 * MiB;
constexpr size_t WS_WUQT = 77 * MiB;
constexpr size_t WS_WUKVT = 86 * MiB;
constexpr size_t WS_WOUTT = 90 * MiB;
constexpr size_t WS_WFF1T = 122 * MiB;
constexpr size_t WS_WFF2T = 250 * MiB;
constexpr size_t WS_H = 378 * MiB;
constexpr size_t WS_QNSA = 506 * MiB;
constexpr size_t WS_KVNSA = 570 * MiB;
constexpr size_t WS_CQ = 666 * MiB;
constexpr size_t WS_CKV = 714 * MiB;
constexpr size_t WS_KPE = 730 * MiB;
constexpr size_t WS_GATES = 732 * MiB;
constexpr size_t WS_RSSQ = 735 * MiB;
constexpr size_t WS_RSSKV = 737 * MiB;
constexpr size_t WS_HIDK = 738 * MiB, WS_HIDV = 740 * MiB;
constexpr size_t WS_KC = 742 * MiB, WS_VC = 743 * MiB;
constexpr size_t WS_QMLA = 744 * MiB;
constexpr size_t WS_KN = 840 * MiB;
constexpr size_t WS_VM = 904 * MiB;
constexpr size_t WS_NSAACC = 968 * MiB;
constexpr size_t FFH_PSTRIDE = 8 * MiB + 160 * 1024;
constexpr size_t WS_FFH = 506 * MiB;
constexpr size_t WS_Y1 = 1100 * MiB;
constexpr size_t WS_STATS = 1230 * MiB;
constexpr size_t WS_END = 1232 * MiB;
#ifndef FF1_ALIGN
#define FF1_ALIGN false
#endif
#ifndef ATT_KW12
#define ATT_KW12 12
#endif
#ifndef FF2_WGM
#define FF2_WGM 4
#endif
constexpr int CW_BAR = 4096;

constexpr int RING_BYTES = 131072;
constexpr int LDSCTL_OFF = RING_BYTES, MISC_OFF = LDSCTL_OFF + 320;
constexpr int LDS_BYTES = 147456;

__device__ __forceinline__ unsigned cvtpk(float lo, float hi) { f32x2 v = {lo, hi}; bf16x2_t b = __builtin_convertvector(v, bf16x2_t); return __builtin_bit_cast(unsigned, b); }
__device__ __forceinline__ u32x2 pack4(f32x4 v) { u32x2 w; w.x = cvtpk(v[0], v[1]); w.y = cvtpk(v[2], v[3]); return w; }
__device__ __forceinline__ unsigned pack4_fp8(float a, float b, float c, float d) { unsigned w = 0u; w = (unsigned)__builtin_amdgcn_cvt_pk_fp8_f32(a, b, (int)w, false); w = (unsigned)__builtin_amdgcn_cvt_pk_fp8_f32(c, d, (int)w, true); return w; }
__device__ __forceinline__ float wave_sum(float v) {
#pragma unroll
    for (int o = 1; o < 64; o <<= 1) v += __shfl_xor(v, o);
    return v;
}
__device__ __forceinline__ float xhalf_max(float x) { const auto r = __builtin_amdgcn_permlane32_swap(__float_as_uint(x), __float_as_uint(x), false, false); return fmaxf(__uint_as_float(r[0]), __uint_as_float(r[1])); }
__device__ __forceinline__ float xhalf_sum(float x) { const auto r = __builtin_amdgcn_permlane32_swap(__float_as_uint(x), __float_as_uint(x), false, false); return __uint_as_float(r[0]) + __uint_as_float(r[1]); }
__device__ __forceinline__ float quad_sum(float x) {
    x += __int_as_float(__builtin_amdgcn_mov_dpp(__float_as_int(x), 0xB1, 0xf, 0xf, true));
    x += __int_as_float(__builtin_amdgcn_mov_dpp(__float_as_int(x), 0x4E, 0xf, 0xf, true));
    return x; }
__device__ __forceinline__ float rdlane(float v, int l) { return __int_as_float(__builtin_amdgcn_readlane(__float_as_int(v), l)); }

namespace pg8 {
constexpr int BM = 256, BK = 64, HALF = 128, HTB = HALF * BK * 2, STAGE_BYTES = 8 * HTB, NXCD = 8, WGM = 8;
__host__ __device__ __forceinline__ int lds_byte(int r, int c) { const int st = (r >> 4) * 2 + (c >> 5), rr = r & 15, cc = c & 31, ob = rr * 64 + cc * 2; return st * 1024 + (ob ^ (((ob >> 9) & 1) << 5)); }
__host__ __device__ __forceinline__ void stage_rc(int b, int& R, int& C) { const int st = b / 1024, sb = b % 1024, swz = sb ^ (((sb >> 9) & 1) << 5); R = (st >> 1) * 16 + swz / 64; C = (st & 1) * 32 + (swz % 64) / 2; }
__host__ __device__ __forceinline__ int perm32(int rho) { const int n = rho >> 4, i = rho & 15; return 8 * (i >> 2) + 4 * n + (i & 3); }

struct Unit { int pm, pn; };

struct GLin {
    const bf16_t* A; const bf16_t* Bt; unsigned lda2, ldb2; int K;
    __device__ __forceinline__ const char* a_tile(const Unit& u) const { return (const char*)A + (size_t)u.pm * 256 * lda2; }
    __device__ __forceinline__ const char* b_tile(const Unit& u) const { return (const char*)Bt + (size_t)u.pn * 256 * ldb2; }
    __device__ __forceinline__ size_t a_koff(int t) const { return (size_t)t * 128; }
};

struct GBlkA {
    const bf16_t* A; const bf16_t* Bt; unsigned lda2, ldb2; int K;
    __device__ __forceinline__ const char* a_tile(const Unit& u) const { return (const char*)A + (size_t)u.pm * (size_t)(K / 64) * 32768; }
    __device__ __forceinline__ const char* b_tile(const Unit& u) const { return (const char*)Bt + (size_t)u.pn * 256 * ldb2; }
    __device__ __forceinline__ size_t a_koff(int t) const { return (size_t)t * 32768; }
};

struct GBlkAS {
    const bf16_t* A; const bf16_t* Bt; unsigned lda2, ldb2; int K; size_t pstride;
    __device__ __forceinline__ const char* a_tile(const Unit& u) const { return (const char*)A + (size_t)u.pm * pstride; }
    __device__ __forceinline__ const char* b_tile(const Unit& u) const { return (const char*)Bt + (size_t)u.pn * 256 * ldb2; }
    __device__ __forceinline__ size_t a_koff(int t) const { return (size_t)t * 32768; }
};

struct StaticOrder {
    int nM, nN, nwg, G, c, wgm;
    __device__ void init(int M, int N, int G_, int c_, int wgm_ = WGM) { nM = M / BM; nN = N / BM; nwg = nM * nN; G = G_; c = c_; wgm = wgm_; }
    __device__ bool next(int i, Unit& u) const {
        const long L = (long)i * G + c; if (L >= nwg) return false;
        int wgid = (int)L; { const int q = nwg / NXCD, r = nwg % NXCD, xcd = wgid % NXCD, off = wgid / NXCD; wgid = (xcd < r ? xcd * (q + 1) : r * (q + 1) + (xcd - r) * q) + off; }
        const int nig = wgm * nN, gid = wgid / nig, fm = gid * wgm, gsz = (nM - fm) < wgm ? (nM - fm) : wgm;
        u.pm = fm + ((wgid % nig) % gsz); u.pn = (wgid % nig) / gsz; return true;
    }
};
struct ListOrder {
    int n, G, c;
    __device__ bool next(int i, Unit& u) const { const int L = i * G + c; if (L >= n) return false; u.pm = L; u.pn = 0; return true; }
};

struct RangeOrder {
    int start, cnt, nN;
    __device__ bool next(int i, Unit& u) const { if (i >= cnt) return false; const int L = start + i; u.pm = L / nN; u.pn = L - u.pm * nN; return true; }
};

typedef int i32x4 __attribute__((ext_vector_type(4)));
typedef int i32x8 __attribute__((ext_vector_type(8)));
__device__ __forceinline__ i32x8 cat8(bf16x8 lo, bf16x8 hi) { const i32x4 a = __builtin_bit_cast(i32x4, lo), b = __builtin_bit_cast(i32x4, hi); return __builtin_shufflevector(a, b, 0, 1, 2, 3, 4, 5, 6, 7); }
template <class GD, class Epi, class Sched, bool F8 = false, int SCALE_W = 0x7f7f7f7f, int SCALE_A = 0x7f7f7f7f, bool ALIGN = true>
__device__ __forceinline__ void gemm_phase(LAS unsigned char* lds, const GD g, const Sched& S, const Epi& E) {
    const int tid = threadIdx.x, wid = __builtin_amdgcn_readfirstlane(tid >> 6), lane = tid & 63, wr = wid >> 2, wc = wid & 3, fr = lane & 15, fq = lane >> 4;
    const int K = g.K, nt = K / BK;
    unsigned voffA, voffB;
    { int R, C; stage_rc(tid * 16, R, C); const int Rb = Epi::PERM ? ((R & ~31) + perm32(R & 31)) : R;
      voffA = (unsigned)R * g.lda2 + (unsigned)C * 2u; voffB = (unsigned)Rb * g.ldb2 + (unsigned)C * 2u; }
    const size_t pvoffA = (size_t)64 * g.lda2, pvoffB = (size_t)64 * g.ldb2;
    const size_t kstep = (size_t)(BK * 2);
    const size_t hstepA = (size_t)HALF * g.lda2, hstepB = (size_t)HALF * g.ldb2;
    const unsigned ldsw = (unsigned)wid * 1024u;
    const int aoff = lds_byte(wr * 64 + fr, fq * 8), boff = lds_byte(wc * 32 + fr, fq * 8);
#define PG8_SA(b, h) (((b) * 2 + (h)) * HTB)
#define PG8_SB(b, h) ((4 + (b) * 2 + (h)) * HTB)
#define PG8_STAGE(bufoff, gbase, voff) do { _Pragma("unroll") for (int _i = 0; _i < 2; ++_i) \
        __builtin_amdgcn_global_load_lds((const unsigned*)((const char*)(gbase) + (size_t)_i * p##voff + (voff)), (LAS unsigned*)(lds + (bufoff) + ldsw + _i * 8192), 16, 0, 0); } while (0)
#define PG8_LDA(dst, b, h) do { _Pragma("unroll") for (int m = 0; m < 4; ++m) _Pragma("unroll") for (int k = 0; k < 2; ++k) dst[m][k] = *(const LAS bf16x8*)(lds + PG8_SA(b, h) + aoff + m * 2048 + k * 1024); } while (0)
#define PG8_LDB(dst, b, h) do { _Pragma("unroll") for (int n = 0; n < 2; ++n) _Pragma("unroll") for (int k = 0; k < 2; ++k) dst[n][k] = *(const LAS bf16x8*)(lds + PG8_SB(b, h) + boff + n * 2048 + k * 1024); } while (0)
#define PG8_MMA(ai, bj, At, Bt) do { __builtin_amdgcn_s_setprio(1); _Pragma("unroll") for (int m = 0; m < 4; ++m) _Pragma("unroll") for (int n = 0; n < 2; ++n) { \
        if constexpr (F8) { const i32x8 _b8 = cat8(Bt[n][0], Bt[n][1]), _a8 = cat8(At[m][0], At[m][1]); \
            asm volatile("v_mfma_scale_f32_16x16x128_f8f6f4 %0, %1, %2, %0, %3, %4 op_sel_hi:[0,0,0]" : "+v"(acc[ai][bj][m][n]) : "v"(_b8), "v"(_a8), "v"(scw), "v"(sca)); } \
        else { _Pragma("unroll") for (int k = 0; k < 2; ++k) acc[ai][bj][m][n] = __builtin_amdgcn_mfma_f32_16x16x32_bf16(Bt[n][k], At[m][k], acc[ai][bj][m][n], 0, 0, 0); } } \
        __builtin_amdgcn_s_setprio(0); } while (0)
#define PG8_WAIT_V(n) asm volatile("s_waitcnt vmcnt(" #n ")" ::: "memory")
#define PG8_WAIT_L(n) asm volatile("s_waitcnt lgkmcnt(" #n ")" ::: "memory")
#define PG8_BAR __builtin_amdgcn_s_barrier()
#define PG8_SCHED __builtin_amdgcn_sched_barrier(0)
    Unit cur, nxt; int ui = 0;
    if (!S.next(0, cur)) return;
    const int scw = SCALE_W, sca = SCALE_A;
    f32x4 acc[2][2][4][2];
#pragma unroll
    for (int a = 0; a < 2; ++a)
#pragma unroll
        for (int b = 0; b < 2; ++b)
#pragma unroll
            for (int m = 0; m < 4; ++m)
#pragma unroll
                for (int n = 0; n < 2; ++n) acc[a][b][m][n] = (f32x4){0.f, 0.f, 0.f, 0.f};
    bf16x8 At[4][2], B0[2][2], B1[2][2];
    const char* cA = g.a_tile(cur); const char* cB = g.b_tile(cur);
    {
        const char* cA1 = cA + g.a_koff(1);
        PG8_STAGE(PG8_SB(0, 0), cB, voffB); PG8_STAGE(PG8_SB(0, 1), cB + hstepB, voffB); PG8_STAGE(PG8_SA(0, 0), cA, voffA); PG8_STAGE(PG8_SA(0, 1), cA + hstepA, voffA);
        if (wr == 1) PG8_BAR;
        PG8_WAIT_V(2); PG8_BAR;
        PG8_STAGE(PG8_SB(1, 0), cB + kstep, voffB); PG8_STAGE(PG8_SA(1, 0), cA1, voffA); PG8_STAGE(PG8_SB(1, 1), cB + hstepB + kstep, voffB);
        PG8_WAIT_V(6); PG8_BAR;
    }
    for (;;) {
        const bool has_next = S.next(ui + 1, nxt);
        const char* nA = has_next ? g.a_tile(nxt) : cA; const char* nB = has_next ? g.b_tile(nxt) : cB;
        for (int t = 0; t < nt; t += 2) {
            const bool last = (t == nt - 2);
            const char* a1 = cA + g.a_koff(t + 1);
            const char* a2 = last ? nA : cA + g.a_koff(t + 2); const char* b2 = last ? nB : cB + (size_t)(t + 2) * kstep;
            const char* a3 = last ? nA + g.a_koff(1) : cA + g.a_koff(t + 3); const char* b3 = b2 + kstep;
            PG8_LDB(B0, 0, 0); PG8_LDB(B1, 0, 1); PG8_SCHED; PG8_LDA(At, 0, 0); PG8_STAGE(PG8_SA(1, 1), a1 + hstepA, voffA);
            PG8_WAIT_V(8); PG8_WAIT_L(0); PG8_BAR; PG8_MMA(0, 0, At, B0); PG8_MMA(0, 1, At, B1); PG8_BAR; PG8_SCHED;
            PG8_LDA(At, 0, 1); PG8_STAGE(PG8_SB(0, 0), b2, voffB); PG8_STAGE(PG8_SB(0, 1), b2 + hstepB, voffB); PG8_STAGE(PG8_SA(0, 0), a2, voffA);
            PG8_WAIT_V(8); PG8_WAIT_L(0); PG8_BAR; PG8_MMA(1, 0, At, B0); PG8_MMA(1, 1, At, B1); PG8_BAR; PG8_SCHED;
            PG8_LDB(B0, 1, 0); PG8_LDB(B1, 1, 1); PG8_SCHED; PG8_LDA(At, 1, 0); PG8_STAGE(PG8_SA(0, 1), a2 + hstepA, voffA);
            PG8_WAIT_V(8); PG8_WAIT_L(0); PG8_BAR; PG8_MMA(0, 0, At, B0); PG8_MMA(0, 1, At, B1); PG8_BAR; PG8_SCHED;
            PG8_LDA(At, 1, 1); PG8_STAGE(PG8_SB(1, 0), b3, voffB); PG8_STAGE(PG8_SB(1, 1), b3 + hstepB, voffB); PG8_STAGE(PG8_SA(1, 0), a3, voffA);
            PG8_WAIT_V(8); PG8_WAIT_L(0); PG8_BAR; PG8_MMA(1, 0, At, B0); PG8_MMA(1, 1, At, B1); PG8_BAR; PG8_SCHED;
        }
        if constexpr (ALIGN) { if (wr == 0) PG8_BAR; }
        if constexpr (F8) asm volatile("s_nop 15\n\ts_nop 15" ::: "memory");
        E(acc, cur, wr, wc, fr, fq);
        if (!has_next) break;
#pragma unroll
        for (int a = 0; a < 2; ++a)
#pragma unroll
            for (int b = 0; b < 2; ++b)
#pragma unroll
                for (int m = 0; m < 4; ++m)
#pragma unroll
                    for (int n = 0; n < 2; ++n) acc[a][b][m][n] = (f32x4){0.f, 0.f, 0.f, 0.f};
        cur = nxt; cA = nA; cB = nB; ++ui;
        if constexpr (ALIGN) { if (wr == 1) PG8_BAR; }
    }
    PG8_WAIT_V(0);
    if constexpr (!ALIGN) { if (wr == 0) PG8_BAR; }
    PG8_BAR;
#undef PG8_SA
#undef PG8_SB
#undef PG8_STAGE
#undef PG8_LDA
#undef PG8_LDB
#undef PG8_MMA
#undef PG8_WAIT_V
#undef PG8_WAIT_L
#undef PG8_BAR
#undef PG8_SCHED
}
}

namespace pg8 {
struct GCmp1 {
    const bf16_t* KV; const bf16_t* K1T; const bf16_t* V1T; unsigned lda2, ldb2; int K;
    __device__ __forceinline__ const char* a_tile(const Unit& u) const { const int which = u.pm >> 4, bg = u.pm & 15, b = bg >> 2, g = bg & 3;
        return (const char*)(KV + (size_t)b * S * 3072 + which * 512 + g * 128); }
    __device__ __forceinline__ const char* b_tile(const Unit& u) const { return (const char*)((u.pm >> 4) ? V1T : K1T); }
    __device__ __forceinline__ size_t a_koff(int t) const { return ((size_t)(t >> 1) * 3072 + (size_t)(t & 1) * 64) * 2; }
};
struct GCmp2 {
    const bf16_t* HK; const bf16_t* HV; const bf16_t* K2T; const bf16_t* V2T; unsigned lda2, ldb2; int K;
    __device__ __forceinline__ const char* a_tile(const Unit& u) const { return (const char*)(((u.pm >> 4) ? HV : HK) + (size_t)(u.pm & 15) * 256 * 256); }
    __device__ __forceinline__ const char* b_tile(const Unit& u) const { return (const char*)((u.pm >> 4) ? V2T : K2T); }
    __device__ __forceinline__ size_t a_koff(int t) const { return (size_t)t * 128; }
};

typedef f32x4 Acc[2][2][4][2];

struct EpiInProj {
    static constexpr bool PERM = false;
    bf16_t *Q, *KV, *CQ, *CKV; float *rssq, *rsskv; const float *ropeP;
    __device__ __forceinline__ void operator()(const Acc& acc, const Unit& u, int wr, int wc, int fr, int fq) const {
        { const int ln = (int)__builtin_amdgcn_mbcnt_hi(~0u, __builtin_amdgcn_mbcnt_lo(~0u, 0u)); fr = ln & 15; fq = ln >> 4; }
        const int pn = u.pn, rowb = u.pm * 256 + wr * 64 + fr;
        if (pn < 20) {
            bf16_t* dst; int ldo; bool rope;
            if (pn < 8) { dst = Q + pn * 256; ldo = 2048; rope = true; } else { dst = KV + (pn - 8) * 256; ldo = 3072; rope = ((((pn - 8) >> 1) & 1) == 0); }
            rope = rope && (wc == 0);
#pragma unroll
            for (int ai = 0; ai < 2; ++ai)
#pragma unroll
                for (int m = 0; m < 4; ++m) {
                    const int row = rowb + ai * 128 + m * 16;
                    f32x4 v[2][2];
#pragma unroll
                    for (int bj = 0; bj < 2; ++bj) { v[bj][0] = acc[ai][bj][m][0]; v[bj][1] = acc[ai][bj][m][1]; }
                    if (rope) { const f32x4 cs = *(const f32x4*)(ropeP + (size_t)row * 32 + 4 * fq), sn = *(const f32x4*)(ropeP + (size_t)row * 32 + 16 + 4 * fq);
#pragma unroll
                        for (int bj = 0; bj < 2; ++bj) { const f32x4 x1 = v[bj][0], x2 = v[bj][1]; v[bj][0] = x1 * cs - x2 * sn; v[bj][1] = x2 * cs + x1 * sn; } }
                    bf16_t* rp = dst + (size_t)row * ldo + wc * 32 + 4 * fq;
#pragma unroll
                    for (int bj = 0; bj < 2; ++bj)
#pragma unroll
                        for (int n = 0; n < 2; ++n) *(u32x2*)(rp + bj * 128 + n * 16) = pack4(v[bj][n]);
                }
        } else {
            const bool isq = pn < 26; const int tc = isq ? pn - 20 : pn - 26;
            bf16_t* dst = isq ? CQ + tc * 256 : CKV + tc * 256; const int ldo = isq ? QR : KVR;
#pragma unroll
            for (int ai = 0; ai < 2; ++ai)
#pragma unroll
                for (int m = 0; m < 4; ++m) {
                    const int row = rowb + ai * 128 + m * 16; float ss = 0.f;
                    bf16_t* rp = dst + (size_t)row * ldo + wc * 32 + 4 * fq; unsigned char* rp8 = (unsigned char*)(isq ? CQ : CKV) + (size_t)row * ldo + tc * 256 + wc * 32 + 4 * fq;
#pragma unroll
                    for (int bj = 0; bj < 2; ++bj)
#pragma unroll
                        for (int n = 0; n < 2; ++n) { const f32x4 x = acc[ai][bj][m][n]; ss += (x[0] * x[0] + x[1] * x[1]) + (x[2] * x[2] + x[3] * x[3]);
                            if constexpr (FP8_UP) *(unsigned*)(rp8 + bj * 128 + n * 16) = pack4_fp8(x[0], x[1], x[2], x[3]); else *(u32x2*)(rp + bj * 128 + n * 16) = pack4(x); }
                    ss += __shfl_xor(ss, 16); ss += __shfl_xor(ss, 32);
                    if (fq == 0) { if (isq) rssq[(size_t)row * 24 + tc * 4 + wc] = ss; else rsskv[(size_t)row * 8 + tc * 4 + wc] = ss; }
                }
        }
    }
};
struct EpiMisc {
    static constexpr bool PERM = false;
    bf16_t* KPE; float* gates; const float* ropeM;
    __device__ __forceinline__ void operator()(const Acc& acc, const Unit& u, int wr, int wc, int fr, int fq) const {
        { const int ln = (int)__builtin_amdgcn_mbcnt_hi(~0u, __builtin_amdgcn_mbcnt_lo(~0u, 0u)); fr = ln & 15; fq = ln >> 4; }
        const int rowb = u.pm * 256 + wr * 64 + fr;
        {
#pragma unroll
            for (int ai = 0; ai < 2; ++ai)
#pragma unroll
                for (int m = 0; m < 4; ++m) {
                    const int row = rowb + ai * 128 + m * 16;
                    if (wc < 2) {
                        const int i0 = 16 * wc + 4 * fq;
                        const f32x4 cs = *(const f32x4*)(ropeM + (size_t)row * 64 + i0), sn = *(const f32x4*)(ropeM + (size_t)row * 64 + 32 + i0);
                        const f32x4 x1 = acc[ai][0][m][0], x2 = acc[ai][0][m][1];
                        *(u32x2*)(KPE + (size_t)row * 64 + i0) = pack4(x1 * cs - x2 * sn);
                        *(u32x2*)(KPE + (size_t)row * 64 + 32 + i0) = pack4(x2 * cs + x1 * sn);
                    } else {
#pragma unroll
                        for (int n = 0; n < 2; ++n) { const int gi = 32 * (wc - 2) + 16 * n + 4 * fq;
                            if (gi < 48) { const f32x4 x = acc[ai][0][m][n]; f32x4 o;
#pragma unroll
                                for (int e = 0; e < 4; ++e) o[e] = 1.0f / (1.0f + __expf(-x[e]));
                                *(f32x4*)(gates + (size_t)row * 48 + gi) = o; } }
                    }
                }
        }
    }
};

struct EpiQUp {
    static constexpr bool PERM = false;
    bf16_t* Qm; const LAS float* rf; int row0; const float* ropeM;
    __device__ __forceinline__ void operator()(const Acc& acc, const Unit& u, int wr, int wc, int fr, int fq) const {
        { const int ln = (int)__builtin_amdgcn_mbcnt_hi(~0u, __builtin_amdgcn_mbcnt_lo(~0u, 0u)); fr = ln & 15; fq = ln >> 4; }
        const int pn = u.pn, rowb = u.pm * 256 + wr * 64 + fr;
#pragma unroll
        for (int ai = 0; ai < 2; ++ai)
#pragma unroll
            for (int m = 0; m < 4; ++m) {
                const int row = rowb + ai * 128 + m * 16;
                const float r = rf[row - row0];
                bf16_t* qrow = Qm + (size_t)row * 3072;
                if (pn < 8) {
#pragma unroll
                    for (int bj = 0; bj < 2; ++bj)
#pragma unroll
                        for (int n = 0; n < 2; ++n) *(u32x2*)(qrow + (2 * pn + bj) * 192 + wc * 32 + n * 16 + 4 * fq) = pack4(acc[ai][bj][m][n] * r);
                } else {
                    const int i0 = 16 * (wc & 1) + 4 * fq;
                    const f32x4 cs = *(const f32x4*)(ropeM + (size_t)row * 64 + i0), sn = *(const f32x4*)(ropeM + (size_t)row * 64 + 32 + i0);
#pragma unroll
                    for (int bj = 0; bj < 2; ++bj) { const int head = (pn - 8) * 4 + bj * 2 + (wc >> 1);
                        const f32x4 x1 = acc[ai][bj][m][0] * r, x2 = acc[ai][bj][m][1] * r;
                        *(u32x2*)(qrow + head * 192 + 128 + i0) = pack4(x1 * cs - x2 * sn);
                        *(u32x2*)(qrow + head * 192 + 160 + i0) = pack4(x2 * cs + x1 * sn); }
                }
                asm volatile("" ::: "memory");
            }
    }
};
struct EpiKVUp {
    static constexpr bool PERM = false;
    bf16_t *KN, *VM; const LAS float* rf; int row0;
    __device__ __forceinline__ void operator()(const Acc& acc, const Unit& u, int wr, int wc, int fr, int fq) const {
        { const int ln = (int)__builtin_amdgcn_mbcnt_hi(~0u, __builtin_amdgcn_mbcnt_lo(~0u, 0u)); fr = ln & 15; fq = ln >> 4; }
        const int pn = u.pn, rowb = u.pm * 256 + wr * 64 + fr;
        bf16_t* dst = pn < 8 ? KN + pn * 256 : VM + (pn - 8) * 256;
#pragma unroll
        for (int ai = 0; ai < 2; ++ai)
#pragma unroll
            for (int m = 0; m < 4; ++m) {
                const int row = rowb + ai * 128 + m * 16;
                const float r = rf[row - row0];
                bf16_t* rp = dst + (size_t)row * 2048 + wc * 32 + 4 * fq;
#pragma unroll
                for (int bj = 0; bj < 2; ++bj)
#pragma unroll
                    for (int n = 0; n < 2; ++n) *(u32x2*)(rp + bj * 128 + n * 16) = pack4(acc[ai][bj][m][n] * r);
                asm volatile("" ::: "memory");
            }
    }
};
struct EpiCmpHid {
    static constexpr bool PERM = false;
    bf16_t *HK, *HV; const float* bias;
    __device__ __forceinline__ void operator()(const Acc& acc, const Unit& u, int wr, int wc, int fr, int fq) const {
        { const int ln = (int)__builtin_amdgcn_mbcnt_hi(~0u, __builtin_amdgcn_mbcnt_lo(~0u, 0u)); fr = ln & 15; fq = ln >> 4; }
        const int which = u.pm >> 4; bf16_t* dst = (which ? HV : HK) + (size_t)(u.pm & 15) * 256 * 256; const float* bs = bias + which * 256;
#pragma unroll
        for (int bj = 0; bj < 2; ++bj)
#pragma unroll
            for (int n = 0; n < 2; ++n) { const int col = bj * 128 + wc * 32 + n * 16 + 4 * fq; const f32x4 bv = *(const f32x4*)(bs + col);
#pragma unroll
                for (int ai = 0; ai < 2; ++ai)
#pragma unroll
                    for (int m = 0; m < 4; ++m) { const int rl = ai * 128 + wr * 64 + m * 16 + fr; const f32x4 x = acc[ai][bj][m][n] + bv; f32x4 o;
#pragma unroll
                        for (int e = 0; e < 4; ++e) { const float v = x[e], uu = 0.7978845608028654f * (v + 0.044715f * v * v * v); const float tt = __builtin_amdgcn_exp2f(uu * (2.0f * LOG2E)); o[e] = v - v / (tt + 1.0f); }
                        if (rl == 255) o = (f32x4){0.f, 0.f, 0.f, 0.f};
                        *(u32x2*)(dst + (size_t)rl * 256 + col) = pack4(o); } }
    }
};
struct EpiCmpOut {
    static constexpr bool PERM = false;
    bf16_t *KC, *VC;
    __device__ __forceinline__ void operator()(const Acc& acc, const Unit& u, int wr, int wc, int fr, int fq) const {
        { const int ln = (int)__builtin_amdgcn_mbcnt_hi(~0u, __builtin_amdgcn_mbcnt_lo(~0u, 0u)); fr = ln & 15; fq = ln >> 4; }
        bf16_t* dst = ((u.pm >> 4) ? VC : KC) + (size_t)(u.pm & 15) * 256 * 128;
#pragma unroll
        for (int ai = 0; ai < 2; ++ai)
#pragma unroll
            for (int m = 0; m < 4; ++m) { const int rl = ai * 128 + wr * 64 + m * 16 + fr;
#pragma unroll
                for (int n = 0; n < 2; ++n) *(u32x2*)(dst + (size_t)rl * 128 + wc * 32 + n * 16 + 4 * fq) = pack4(acc[ai][0][m][n]); }
    }
};
__device__ __forceinline__ void unpack8(u32x4 w, f32x4& lo, f32x4& hi) {
    lo[0] = __uint_as_float(w.x << 16); lo[1] = __uint_as_float(w.x & 0xffff0000u); lo[2] = __uint_as_float(w.y << 16); lo[3] = __uint_as_float(w.y & 0xffff0000u);
    hi[0] = __uint_as_float(w.z << 16); hi[1] = __uint_as_float(w.z & 0xffff0000u); hi[2] = __uint_as_float(w.w << 16); hi[3] = __uint_as_float(w.w & 0xffff0000u);
}
__device__ __forceinline__ u32x4 pack8f(f32x4 lo, f32x4 hi) { u32x4 w; w.x = cvtpk(lo[0], lo[1]); w.y = cvtpk(lo[2], lo[3]); w.z = cvtpk(hi[0], hi[1]); w.w = cvtpk(hi[2], hi[3]); return w; }
struct EpiY1 {
    static constexpr bool PERM = true;
    const float* x; bf16_t* y1; const float* gate;
    __device__ __forceinline__ void operator()(const Acc& acc, const Unit& u, int wr, int wc, int fr, int fq) const {
        { const int ln = (int)__builtin_amdgcn_mbcnt_hi(~0u, __builtin_amdgcn_mbcnt_lo(~0u, 0u)); fr = ln & 15; fq = ln >> 4; }
        const int rowb = u.pm * 256 + wr * 64 + fr, col0 = u.pn * 256 + wc * 32 + 8 * fq; const int b = (u.pm * 256) / S;
        const size_t yb = (((size_t)u.pm * 16 + u.pn) * 256 + (wr * 64 + fr)) * 256 + wc * 32 + 8 * fq;
        f32x4 gv[2][2];
#pragma unroll
        for (int bj = 0; bj < 2; ++bj)
#pragma unroll
            for (int n = 0; n < 2; ++n) gv[bj][n] = *(const f32x4*)(gate + (size_t)b * NADA + col0 + bj * 128 + n * 4) + 1.0f;
        f32x4 bsA[2][2][2], bsB[2][2][2];
#define Y1_LOAD(dst, am) do { _Pragma("unroll") for (int mm = 0; mm < 2; ++mm) { const int m_ = ((am) & 1) * 2 + mm; const size_t off_ = (size_t)(rowb + ((am) >> 1) * 128 + m_ * 16) * D + col0; \
            _Pragma("unroll") for (int bj = 0; bj < 2; ++bj) _Pragma("unroll") for (int n = 0; n < 2; ++n) dst[mm][bj][n] = *(const f32x4*)(x + off_ + bj * 128 + n * 4); } } while (0)
#define Y1_STORE(src, am) do { _Pragma("unroll") for (int mm = 0; mm < 2; ++mm) { const int ai_ = (am) >> 1, m_ = ((am) & 1) * 2 + mm; const size_t off_ = yb + (size_t)(ai_ * 128 + m_ * 16) * 256;        \
            _Pragma("unroll") for (int bj = 0; bj < 2; ++bj) *(u32x4*)(y1 + off_ + bj * 128) = pack8f(src[mm][bj][0] * ALPHA + gv[bj][0] * acc[ai_][bj][m_][0], src[mm][bj][1] * ALPHA + gv[bj][1] * acc[ai_][bj][m_][1]); } } while (0)
        Y1_LOAD(bsA, 0);
        Y1_LOAD(bsB, 1); asm volatile("" ::: "memory");
        Y1_STORE(bsA, 0); asm volatile("" ::: "memory");
        Y1_LOAD(bsA, 2); asm volatile("" ::: "memory");
        Y1_STORE(bsB, 1); asm volatile("" ::: "memory");
        Y1_LOAD(bsB, 3); asm volatile("" ::: "memory");
        Y1_STORE(bsA, 2); asm volatile("" ::: "memory");
        Y1_STORE(bsB, 3);
#undef Y1_LOAD
#undef Y1_STORE
    }
};
struct EpiY2 {
    static constexpr bool PERM = true;
    const bf16_t* y1; bf16_t* y2; const float* gate; const float* stats; const float* lg; const float* lb;
    __device__ __forceinline__ void operator()(const Acc& acc, const Unit& u, int wr, int wc, int fr, int fq) const {
        { const int ln = (int)__builtin_amdgcn_mbcnt_hi(~0u, __builtin_amdgcn_mbcnt_lo(~0u, 0u)); fr = ln & 15; fq = ln >> 4; }
        const int rowb = u.pm * 256 + wr * 64 + fr, col0 = u.pn * 256 + wc * 32 + 8 * fq; const int b = (u.pm * 256) / S;
        const size_t yb = (((size_t)u.pm * 16 + u.pn) * 256 + (wr * 64 + fr)) * 256 + wc * 32 + 8 * fq;
#pragma unroll
        for (int bj = 0; bj < 2; ++bj) {
            f32x4 gm[2], G[2], Bc[2];
#pragma unroll
            for (int n = 0; n < 2; ++n) { const int c = col0 + bj * 128 + n * 4; gm[n] = *(const f32x4*)(gate + (size_t)b * NADA + c) + 1.0f; G[n] = *(const f32x4*)(lg + c) * ALPHA; Bc[n] = *(const f32x4*)(lb + c) * ALPHA; }
#pragma unroll
            for (int hf = 0; hf < 2; ++hf) {
                u32x4 yv[4]; f32x2 st[4];
#pragma unroll
                for (int m = 0; m < 4; ++m) { const int row = rowb + hf * 128 + m * 16; yv[m] = *(const u32x4*)(y1 + yb + (size_t)(hf * 128 + m * 16) * 256 + bj * 128); st[m] = *(const f32x2*)(stats + (size_t)row * 2); }
#pragma unroll
                for (int m = 0; m < 4; ++m) { const int row = rowb + hf * 128 + m * 16;
                    f32x4 lo, hi; unpack8(yv[m], lo, hi); const float r = st[m][1], mr = st[m][0] * r;
                    lo = (lo * r - mr) * G[0] + Bc[0] + gm[0] * acc[hf][bj][m][0]; hi = (hi * r - mr) * G[1] + Bc[1] + gm[1] * acc[hf][bj][m][1];
                    *(u32x4*)(y2 + yb + (size_t)(hf * 128 + m * 16) * 256 + bj * 128) = pack8f(lo, hi); }
                asm volatile("" ::: "memory");
            }
            asm volatile("" ::: "memory");
        }
    }
};
struct EpiRelu2 {
    static constexpr bool PERM = true;
    bf16_t* O;
    __device__ __forceinline__ void operator()(const Acc& acc, const Unit& u, int wr, int wc, int fr, int fq) const {
        { const int ln = (int)__builtin_amdgcn_mbcnt_hi(~0u, __builtin_amdgcn_mbcnt_lo(~0u, 0u)); fr = ln & 15; fq = ln >> 4; }
        const int rl = wr * 64 + fr, kt0 = u.pn * 4 + (wc >> 1), cl = (wc & 1) * 32 + 8 * fq;
#pragma unroll
        for (int ai = 0; ai < 2; ++ai)
#pragma unroll
            for (int m = 0; m < 4; ++m) { bf16_t* rp = O + (size_t)u.pm * (FFH_PSTRIDE / 2) + ((size_t)kt0 * 256 + (rl + ai * 128 + m * 16)) * 64 + cl;
#pragma unroll
                for (int bj = 0; bj < 2; ++bj) { f32x4 v0 = acc[ai][bj][m][0], v1 = acc[ai][bj][m][1];
#pragma unroll
                    for (int e = 0; e < 4; ++e) { const float a = fmaxf(v0[e], 0.f), b = fmaxf(v1[e], 0.f); v0[e] = a * a; v1[e] = b * b; }
                    u32x4 w; w.x = cvtpk(v0[0], v0[1]); w.y = cvtpk(v0[2], v0[3]); w.z = cvtpk(v1[0], v1[1]); w.w = cvtpk(v1[2], v1[3]);
                    *(u32x4*)(rp + (size_t)bj * 2 * 256 * 64) = w; } }
    }
};
}

typedef GAS unsigned gu32;
#define RLX_AGENT __ATOMIC_RELAXED, __HIP_MEMORY_SCOPE_AGENT
#define XB_TMO      128
#define XB_XCNT(j)  (256  + 64 * (j))
#define XB_XSUB(j)  (1280 + 64 * (j))
#define XB_XGEN(j)  (2304 + 64 * (j))
#define XB_TOP      3328
#define XB_TOPGEN   3392
#define XCD_BAR_WORDS 3456
#define XB_SPIN_CAP (1u << 20)

__device__ __forceinline__ unsigned xb_ld(unsigned* p)              { return __hip_atomic_load(p, __ATOMIC_RELAXED, __HIP_MEMORY_SCOPE_AGENT); }
__device__ __forceinline__ unsigned xb_add(unsigned* p, unsigned v) { return __hip_atomic_fetch_add(p, v, __ATOMIC_RELAXED, __HIP_MEMORY_SCOPE_AGENT); }
__device__ __forceinline__ unsigned xb_xcc_id() { return (unsigned)__builtin_amdgcn_s_getreg((3 << 11) | 20) & 0xFu; }
#define XB_SPIN(cond, bar) do { unsigned _sp = 0; while (cond) { __builtin_amdgcn_s_sleep(1); \
    if ((++_sp & 255u) == 0u) { if (xb_ld(&(bar)[XB_TMO])) break; if (_sp > XB_SPIN_CAP) { atomicAdd(&(bar)[XB_TMO], 1u); break; } } } } while (0)

struct XcdBarrier { unsigned* bar; unsigned x; volatile LAS unsigned* st; };

__device__ __forceinline__ XcdBarrier xcd_barrier_post(unsigned* bar, volatile LAS unsigned* st) {
    XcdBarrier b; b.bar = bar; b.x = xb_xcc_id(); b.st = st;
    if (threadIdx.x == 0) (void)xb_add(&bar[XB_XCNT(b.x)], 1u);
    return b;
}
__device__ __forceinline__ void xcd_barrier_complete(unsigned* bar, unsigned x, unsigned& nloc, unsigned& nx) {
    const unsigned G = gridDim.x * gridDim.y * gridDim.z;
    unsigned sum, cnt, mine, sp = 0u;
    for (;;) {
        sum = 0u; cnt = 0u; mine = 0u;
#pragma unroll
        for (unsigned j = 0; j < 16; ++j) { const unsigned c = xb_ld(&bar[XB_XCNT(j)]); sum += c; cnt += (c > 0u) ? 1u : 0u; mine = (j == x) ? c : mine; }
        if (sum == G) break;
        __builtin_amdgcn_s_sleep(1);
        if ((++sp & 255u) == 0u) { if (xb_ld(&bar[XB_TMO])) break; if (sp > XB_SPIN_CAP) { atomicAdd(&bar[XB_TMO], 1u); break; } }
    }
    nloc = mine > 0u ? mine : 1u; nx = cnt > 0u ? cnt : 1u;
}
__device__ __forceinline__ void xcd_barrier(const XcdBarrier& b) {
    asm volatile("s_waitcnt vmcnt(0)" ::: "memory");
    __syncthreads();
    if (threadIdx.x == 0) {
        unsigned* bar = b.bar;
        __builtin_amdgcn_s_waitcnt(0);
        unsigned nloc = b.st[0], nx = b.st[1];
        if (nloc == 0u) { xcd_barrier_complete(bar, b.x, nloc, nx); b.st[0] = nloc; b.st[1] = nx; }
        const unsigned old = xb_add(&bar[XB_XSUB(b.x)], 1u);
        const unsigned gen = old / nloc;
        if (old + 1u == (gen + 1u) * nloc) {
            __builtin_amdgcn_fence(__ATOMIC_RELEASE, "agent");
            asm volatile("s_waitcnt vmcnt(0)" ::: "memory");
            const unsigned og = xb_add(&bar[XB_TOP], 1u);
            const unsigned tg = og / nx;
            if (og + 1u == (tg + 1u) * nx) xb_add(&bar[XB_TOPGEN], 1u);
            else XB_SPIN(xb_ld(&bar[XB_TOPGEN]) == tg, bar);
            __builtin_amdgcn_fence(__ATOMIC_ACQUIRE, "agent");
            xb_add(&bar[XB_XGEN(b.x)], 1u);
            asm volatile("s_waitcnt vmcnt(0)" ::: "memory");
        } else {
            XB_SPIN(xb_ld(&bar[XB_XGEN(b.x)]) == gen, bar);
            __builtin_amdgcn_fence(__ATOMIC_ACQUIRE, "agent");
            asm volatile("s_waitcnt vmcnt(0)" ::: "memory");
        }
    }
    __syncthreads();
}

struct Frame {
    LAS unsigned char* lds;
    volatile LAS unsigned* MISC;
    int tid, lane, wave, vcu, G;
    unsigned char* ws;
    const float *x, *c, *w_ada, *b_ada, *w_in, *pos_k, *pos_v, *k1, *k2, *v1, *v2, *qn, *kvn, *w_uq, *w_ukv, *w_out, *ln1g, *ln1b, *w_ff1, *w_ff2, *ln2g, *ln2b;
    const int* positions;
    float* out;
};

__device__ __forceinline__ int pairperm64(int p) { const int blk = p >> 4, i = p & 15; return blk == 0 ? i : (blk == 1 ? 32 + i : (blk == 2 ? 16 + i : 48 + i)); }
struct MapId { __device__ __forceinline__ int operator()(int j) const { return j; } };
struct MapPad { int n; __device__ __forceinline__ int operator()(int j) const { return j < n ? j : -1; } };
struct MapWin { __device__ __forceinline__ int operator()(int j) const {
    if (j < 5120) return j;
    if (j < 6656) return 5168 + (j - 5120);
    if (j < 7168) return 6704 + (j - 6656);
    const int jj = j - 7168;
    if (jj < 64) return 7216 + pairperm64(jj);
    if (jj < 112) return 5120 + (jj - 64);
    return -1; } };
struct MapUq { __device__ __forceinline__ int operator()(int j) const {
    if (j < 2048) return (j >> 7) * 192 + (j & 127);
    const int jj = j - 2048; return (jj >> 6) * 192 + 128 + pairperm64(jj & 63); } };
struct MapUkv { __device__ __forceinline__ int operator()(int j) const {
    if (j < 2048) return (j >> 7) * 256 + (j & 127);
    const int jj = j - 2048; return (jj >> 7) * 256 + 128 + (jj & 127); } };

__device__ __forceinline__ void blk8(int r, int KBs, int& kb, int& nb) { const int g = r >> 6, a = r & 63, gk = KBs >> 3; kb = 8 * (g % gk) + (a >> 3); nb = 8 * (g / gk) + (a & 7); }
__device__ __forceinline__ void blk16(int r, int KBs, int& kb, int& nb) { const int g = r >> 8, a = r & 255, gk = KBs >> 4; kb = 16 * (g % gk) + (a >> 4); nb = 16 * (g / gk) + (a & 15); }
template <bool F8 = false, class Map>
__device__ __forceinline__ void transpose_item(const float* __restrict__ W, int Nsrc, int K, void* WTv, const float* kscale, float mul, LAS float* scr, int kb, int nb, int lane, const Map map) {
    const int k0 = 64 * kb, j0 = 32 * nb, sc = map(j0 + (lane & 31)), kh = lane >> 5;
    float v[32];
#pragma unroll
    for (int i = 0; i < 32; ++i) v[i] = sc >= 0 ? W[(size_t)(k0 + 2 * i + kh) * Nsrc + sc] : 0.f;
    if (kscale) {
#pragma unroll
        for (int i = 0; i < 32; ++i) v[i] *= kscale[k0 + 2 * i + kh];
    }
#pragma unroll
    for (int i = 0; i < 32; ++i) scr[(2 * i + kh) * 33 + (lane & 31)] = v[i];
    asm volatile("s_waitcnt lgkmcnt(0)" ::: "memory");
    if constexpr (F8) {
        unsigned char* WT = (unsigned char*)WTv; const int c = lane & 3;
#pragma unroll
        for (int jj = 0; jj < 2; ++jj) { const int n = (lane >> 2) + 16 * jj; const LAS float* s = scr + (16 * c) * 33 + n;
            u32x4 o; o.x = pack4_fp8(s[0 * 33] * mul, s[1 * 33] * mul, s[2 * 33] * mul, s[3 * 33] * mul); o.y = pack4_fp8(s[4 * 33] * mul, s[5 * 33] * mul, s[6 * 33] * mul, s[7 * 33] * mul);
            o.z = pack4_fp8(s[8 * 33] * mul, s[9 * 33] * mul, s[10 * 33] * mul, s[11 * 33] * mul); o.w = pack4_fp8(s[12 * 33] * mul, s[13 * 33] * mul, s[14 * 33] * mul, s[15 * 33] * mul);
            *(u32x4*)(WT + (size_t)(j0 + n) * K + k0 + 16 * c) = o; }
    } else {
        bf16_t* WT = (bf16_t*)WTv; const int c = lane & 7;
#pragma unroll
        for (int jj = 0; jj < 4; ++jj) { const int n = (lane >> 3) + 8 * jj; const LAS float* s = scr + (8 * c) * 33 + n;
            u32x4 o; o.x = cvtpk(s[0 * 33], s[1 * 33]); o.y = cvtpk(s[2 * 33], s[3 * 33]); o.z = cvtpk(s[4 * 33], s[5 * 33]); o.w = cvtpk(s[6 * 33], s[7 * 33]);
            *(u32x4*)(WT + (size_t)(j0 + n) * K + k0 + 8 * c) = o; }
    }
    asm volatile("s_waitcnt lgkmcnt(0)" ::: "memory");
}

__device__ const double INVM[32] = {1.0, 0.6636012376960885, 0.44036660267178046, 0.2922278225730151, 0.19392274474868576, 0.12868737343265052, 0.08539710028576561, 0.05666962144529105,
    0.03760603093086393, 0.024955408670558694, 0.016560440080994446, 0.010989528534539826, 0.007292664737217109, 0.004839421345719893, 0.003211445994752591, 0.0021311195369119653,
    0.001414213562373095, 0.0009384738703573802, 0.000622772421914596, 0.0004132725499855165, 0.0002742481756762073, 0.00018199142881462546, 0.00012076973741146504, 8.01429472224798e-05,
    5.318295896944988e-05, 3.529227739646723e-05, 2.341999896140934e-05, 1.5541540297632344e-05, 1.031338537721246e-05, 6.8439753011549275e-06, 4.5416704806078695e-06, 3.013858152139171e-06};
__device__ __forceinline__ void sincos_d(double a, float& s, float& c) {
    const double k = __builtin_rint(a * 0.63661977236758134308);
    double r = __builtin_fma(-k, 1.57079632679489655800e+00, a); r = __builtin_fma(-k, 6.12323399573676603587e-17, r);
    const double r2 = r * r;
    double sp = -7.6471637318198164759e-13; sp = sp * r2 + 1.6059043836821614599e-10; sp = sp * r2 - 2.5052108385441718775e-08; sp = sp * r2 + 2.7557319223985890653e-06;
    sp = sp * r2 - 1.9841269841269841270e-04; sp = sp * r2 + 8.3333333333333333333e-03; sp = sp * r2 - 1.6666666666666666667e-01; const double sr = r + r * r2 * sp;
    double cp = 4.7794773323873852974e-14; cp = cp * r2 - 1.1470745597729724714e-11; cp = cp * r2 + 2.0876756987868098979e-09; cp = cp * r2 - 2.7557319223985890653e-07;
    cp = cp * r2 + 2.4801587301587301587e-05; cp = cp * r2 - 1.3888888888888888889e-03; cp = cp * r2 + 4.1666666666666666667e-02; cp = cp * r2 - 0.5; const double cr = 1.0 + r2 * cp;
    const int q = (int)k & 3;
    const double ss = (q == 0) ? sr : (q == 1) ? cr : (q == 2) ? -sr : -cr;
    const double cc = (q == 0) ? cr : (q == 1) ? -sr : (q == 2) ? -cr : sr;
    s = (float)ss; c = (float)cc;
}

__device__ __forceinline__ void p0_prologue(Frame& F) {
    unsigned char* ws = F.ws;
    const int gw = F.vcu * 8 + F.wave, NGW = F.G * 8, lane = F.lane;
    {
        float* modp = (float*)(ws + WS_MODP);
        for (int it = gw; it < 96 * ADA_KCH; it += NGW) {
            const int cc = it % 96, kc = it / 96, col = 256 * cc + 4 * lane;
            f32x4 a0 = {0.f, 0.f, 0.f, 0.f}, a1 = a0, a2 = a0, a3 = a0;
            for (int k8 = 0; k8 < 4; ++k8) {
                const int kbase = 256 * kc + 64 * k8;
                float s0, s1, s2, s3;
                { const float x0 = F.c[0 * D + kbase + lane], x1 = F.c[1 * D + kbase + lane], x2 = F.c[2 * D + kbase + lane], x3 = F.c[3 * D + kbase + lane];
                  s0 = x0 / (1.f + expf(-x0)); s1 = x1 / (1.f + expf(-x1)); s2 = x2 / (1.f + expf(-x2)); s3 = x3 / (1.f + expf(-x3)); }
                const float* wp = F.w_ada + (size_t)kbase * NADA + col;
#pragma unroll 16
                for (int kk = 0; kk < 64; ++kk) { const f32x4 w = *(const f32x4*)(wp + (size_t)kk * NADA);
                    a0 += w * rdlane(s0, kk); a1 += w * rdlane(s1, kk); a2 += w * rdlane(s2, kk); a3 += w * rdlane(s3, kk); }
            }
            *(f32x4*)(modp + ((size_t)(kc * 4 + 0)) * NADA + col) = a0; *(f32x4*)(modp + ((size_t)(kc * 4 + 1)) * NADA + col) = a1;
            *(f32x4*)(modp + ((size_t)(kc * 4 + 2)) * NADA + col) = a2; *(f32x4*)(modp + ((size_t)(kc * 4 + 3)) * NADA + col) = a3;
        }
    }
    {
        LAS float* scr = (LAS float*)(F.lds + F.wave * 16384);
        constexpr int I_IN = 64 * (DINP / 32), I_UQ = (QR / 64) * (3072 / 32), I_UKV = (KVR / 64) * (4096 / 32), I_OUT = 64 * 128, I_F1 = 64 * 512, I_F2 = 256 * 128, I_C1 = 64 * 8, I_C2 = 4 * 8;
        constexpr int NITEMS = I_IN + I_UQ + I_UKV + I_OUT + I_F1 + I_F2 + 2 * I_C1 + 2 * I_C2;
        for (int it = gw; it < NITEMS; it += NGW) {
            int r = it;
            if (r < I_F1) { int kb, nb; blk16(r, 64, kb, nb); transpose_item(F.w_ff1, DFF, D, (bf16_t*)(ws + WS_WFF1T), nullptr, 1.f, scr, kb, nb, lane, MapId{}); continue; } r -= I_F1;
            if (r < I_F2) { int kb, nb; blk16(r, 256, kb, nb); transpose_item(F.w_ff2, D, DFF, (bf16_t*)(ws + WS_WFF2T), nullptr, 1.f, scr, kb, nb, lane, MapId{}); continue; } r -= I_F2;
            if (r < I_IN) { int kb, nb; blk8(r, 64, kb, nb); transpose_item<FP8_IN>(F.w_in, 7280, D, (void*)(ws + WS_WINT), nullptr, FP8_IN ? 64.f : 1.f, scr, kb, nb, lane, MapWin{}); continue; } r -= I_IN;
            if (r < I_OUT) { int kb, nb; blk16(r, 64, kb, nb); transpose_item<FP8_OUT>(F.w_out, D, D, (void*)(ws + WS_WOUTT), nullptr, FP8_OUT ? 64.f : 1.f, scr, kb, nb, lane, MapId{}); continue; } r -= I_OUT;
            if (r < I_UQ) { transpose_item<FP8_UP>(F.w_uq, 3072, QR, (void*)(ws + WS_WUQT), F.qn, FP8_UP ? 32.f : 1.f, scr, r / 96, r % 96, lane, MapUq{}); continue; } r -= I_UQ;
            if (r < I_UKV) { transpose_item<FP8_UP>(F.w_ukv, 4096, KVR, (void*)(ws + WS_WUKVT), F.kvn, FP8_UP ? 16.f : 1.f, scr, r / 128, r % 128, lane, MapUkv{}); continue; } r -= I_UKV;
            if (r < I_C1) { transpose_item(F.k1, 256, 4096, (bf16_t*)(ws + WS_K1T), nullptr, 1.f, scr, r / 8, r % 8, lane, MapId{}); continue; } r -= I_C1;
            if (r < I_C1) { transpose_item(F.v1, 256, 4096, (bf16_t*)(ws + WS_V1T), nullptr, 1.f, scr, r / 8, r % 8, lane, MapId{}); continue; } r -= I_C1;
            if (r < I_C2) { transpose_item(F.k2, 128, 256, (bf16_t*)(ws + WS_SMALL + 65536), nullptr, 1.f, scr, r / 8, r % 8, lane, MapPad{128}); continue; } r -= I_C2;
            transpose_item(F.v2, 128, 256, (bf16_t*)(ws + WS_SMALL + 196608), nullptr, 1.f, scr, r / 8, r % 8, lane, MapPad{128});
        }
    }
    {
        float* rp = (float*)(ws + WS_ROPEP); float* rm = (float*)(ws + WS_ROPEM);
        const int gt = (F.vcu * 8 + F.wave) * 64 + lane, NT = F.G * 512;
        for (int e = gt; e < T * 32; e += NT) {
            const int t = e >> 5, i = e & 31;
            const double inv = INVM[i];
            float s, c; sincos_d((double)F.positions[t] * inv, s, c);
            rm[(size_t)t * 64 + i] = c; rm[(size_t)t * 64 + 32 + i] = s;
            if ((i & 1) == 0) { rp[(size_t)t * 32 + (i >> 1)] = c; rp[(size_t)t * 32 + 16 + (i >> 1)] = s; }
        }
    }
    {
        float* bias = (float*)(ws + WS_SMALL);
        for (int it = gw; it < 128; it += NGW) {
            const int which = it >> 6, cg = it & 63; const float* pos = which ? F.pos_v : F.pos_k; const float* w1 = which ? F.v1 : F.k1;
            f32x4 a = {0.f, 0.f, 0.f, 0.f};
            for (int k = lane; k < 4096; k += 64) a += *(const f32x4*)(w1 + (size_t)k * 256 + 4 * cg) * pos[k];
#pragma unroll
            for (int e = 0; e < 4; ++e) a[e] = wave_sum(a[e]);
            if (lane == 0) *(f32x4*)(bias + which * 256 + 4 * cg) = a;
        }
    }
}

__device__ __forceinline__ void p1_modulate(Frame& F) {
    unsigned char* ws = F.ws; const float* modp = (const float*)(ws + WS_MODP); float* modf = (float*)(ws + WS_MODF);
    if (blockIdx.x < 96) {
        for (int e = F.tid; e < 1024; e += 512) { const int idx = blockIdx.x * 1024 + e, col = idx % NADA; float s = F.b_ada[col];
#pragma unroll
            for (int kc = 0; kc < ADA_KCH; ++kc) s += modp[(size_t)kc * 4 * NADA + idx];
            modf[idx] = s; }
    }
    const int w = F.vcu, b = (w * 64) / S;
    LAS float* sh = (LAS float*)F.lds; LAS float* sc = sh + D;
    for (int e = F.tid; e < 2 * D; e += 512) { float s = F.b_ada[e];
#pragma unroll
        for (int kc = 0; kc < ADA_KCH; ++kc) s += modp[((size_t)kc * 4 + b) * NADA + e];
        sh[e] = (e < D) ? s : s + 1.0f; }
    __syncthreads();
    unsigned char* H8 = ws + WS_H;
    for (int rr = 0; rr < 8; ++rr) {
        const int row = w * 64 + F.wave * 8 + rr; const f32x4* xr = (const f32x4*)(F.x + (size_t)row * D); unsigned* hr = (unsigned*)(H8 + (size_t)row * D);
        f32x4 xv[16];
#pragma unroll
        for (int i = 0; i < 16; ++i) xv[i] = xr[F.lane + 64 * i];
        __builtin_amdgcn_sched_barrier(0);
#pragma unroll
        for (int i = 0; i < 16; ++i) { const int q = F.lane + 64 * i; const f32x4 sv = *(LAS f32x4*)(sc + 4 * q), hv = *(LAS f32x4*)(sh + 4 * q); const f32x4 o = xv[i] * sv + hv;
            if constexpr (FP8_IN) *(unsigned*)(H8 + ((((size_t)(row >> 8) * 32) + (q >> 5)) * 256 + (row & 255)) * 128 + 4 * (q & 31)) = pack4_fp8(o[0], o[1], o[2], o[3]); else        ((u32x2*)((bf16_t*)(ws + WS_H) + (size_t)row * D))[q] = pack4(o); }
    }
    __syncthreads();
}

__device__ __forceinline__ size_t ytile(int row, int col) { return ((((size_t)(row >> 8) * 16) + (col >> 8)) * 256 + (row & 255)) * 256 + (col & 255); }
template <bool LN1>
__device__ __forceinline__ void ln_phase(Frame& F, const bf16_t* Yin, const float* ga, const float* be, const float* modf, float* stats, bf16_t* ob16, float* of32) {
    const int lane = F.lane, w = F.wave, c0 = 512 * w + 8 * lane;
    LAS f32x2* red = (LAS f32x2*)F.lds;
    for (int rb = F.vcu * 64; rb < T; rb += F.G * 64) {
        const int b = rb / S;
        f32x4 ca[2], cb[2];
#pragma unroll
        for (int n = 0; n < 2; ++n) {
            if (LN1) { const f32x4 sc1 = *(const f32x4*)(modf + (size_t)b * NADA + 4 * D + c0 + 4 * n) + 1.0f, sh = *(const f32x4*)(modf + (size_t)b * NADA + 3 * D + c0 + 4 * n);
                ca[n] = *(const f32x4*)(ga + c0 + 4 * n) * sc1; cb[n] = *(const f32x4*)(be + c0 + 4 * n) * sc1 + sh; }
            else { ca[n] = *(const f32x4*)(ga + c0 + 4 * n); cb[n] = *(const f32x4*)(be + c0 + 4 * n); }
        }
        u32x4 nx[8];
#pragma unroll
        for (int k = 0; k < 8; ++k) nx[k] = *(const u32x4*)(Yin + ytile(rb + k, c0));
        for (int bt = 0; bt < 8; ++bt) {
            const int r0 = rb + 8 * bt; f32x4 v[8][2];
            LAS f32x2* rd = red + (bt & 1) * 64;
#pragma unroll
            for (int k = 0; k < 8; ++k) { pg8::unpack8(nx[k], v[k][0], v[k][1]);
                float s = ((v[k][0][0] + v[k][0][1]) + (v[k][0][2] + v[k][0][3])) + ((v[k][1][0] + v[k][1][1]) + (v[k][1][2] + v[k][1][3]));
                float q = ((v[k][0][0] * v[k][0][0] + v[k][0][1] * v[k][0][1]) + (v[k][0][2] * v[k][0][2] + v[k][0][3] * v[k][0][3])) + ((v[k][1][0] * v[k][1][0] + v[k][1][1] * v[k][1][1]) + (v[k][1][2] * v[k][1][2] + v[k][1][3] * v[k][1][3]));
                s = wave_sum(s); q = wave_sum(q);
                if (lane == 0) rd[k * 8 + w] = (f32x2){s, q}; }
            if (bt < 7) {
#pragma unroll
                for (int k = 0; k < 8; ++k) nx[k] = *(const u32x4*)(Yin + ytile(r0 + 8 + k, c0));
            }
            __syncthreads();
#pragma unroll
            for (int k = 0; k < 8; ++k) {
                float s = 0.f, q = 0.f;
#pragma unroll
                for (int ww = 0; ww < 8; ++ww) { const f32x2 p = rd[k * 8 + ww]; s += p[0]; q += p[1]; }
                const float mean = s * (1.0f / D), var = fmaxf(q * (1.0f / D) - mean * mean, 0.f), rstd = 1.0f / sqrtf(var + 1e-5f);
                const size_t ro = (size_t)(r0 + k) * D + c0;
                if (LN1) { if (w == 0 && lane == 0) *(f32x2*)(stats + (size_t)(r0 + k) * 2) = (f32x2){mean, rstd};
                    const int row = r0 + k; const size_t bo = ((((size_t)(row >> 8) * (D / 64)) + (c0 >> 6)) * 256 + (row & 255)) * 64 + (c0 & 63);
                    *(u32x4*)(ob16 + bo) = pg8::pack8f((v[k][0] - mean) * rstd * ca[0] + cb[0], (v[k][1] - mean) * rstd * ca[1] + cb[1]); }
                else { *(f32x4*)(of32 + ro) = (v[k][0] - mean) * rstd * ca[0] + cb[0]; *(f32x4*)(of32 + ro + 4) = (v[k][1] - mean) * rstd * ca[1] + cb[1]; }
            }
        }
        __syncthreads();
    }
}
__device__ __forceinline__ void ln1_phase(Frame& F, const float* modf) {
    ln_phase<true>(F, (const bf16_t*)(F.ws + WS_Y1), F.ln1g, F.ln1b, modf, (float*)(F.ws + WS_STATS), (bf16_t*)(F.ws + WS_H), nullptr);
}
__device__ __forceinline__ void ln2_phase(Frame& F) {
    ln_phase<false>(F, (const bf16_t*)(F.ws + WS_H), F.ln2g, F.ln2b, nullptr, nullptr, nullptr, F.out);
}

namespace att {
constexpr int KP = 400, VP = 320;
constexpr int KBUF = 64 * KP, VBUF = 64 * VP;
constexpr int OFF_K = 0, OFF_V = 2 * KBUF, OFF_IMPG = OFF_V + 2 * VBUF, OFF_IMPL = OFF_IMPG + 16384, OFF_SELM = OFF_IMPL + 16384, OFF_UNI = OFF_SELM + 512;
static_assert(OFF_UNI + 128 <= RING_BYTES, "attention LDS map");
enum { M_CMP1 = 0, M_CMP2 = 1, M_SEL = 2, M_WIN = 3, M_MLA = 4 };

struct Stage { u32x4 k0, k1, kp, v0, v1; };
template <bool HASP, bool HASV>
__device__ __forceinline__ void stage_load(Stage& st, const bf16_t* Kg, size_t ldk, const bf16_t* Pg, const bf16_t* Vg, size_t ldv, int tid) {
    const int r0 = tid >> 4, c0 = (tid & 15) * 8;
    st.k0 = *(const u32x4*)(Kg + (size_t)r0 * ldk + c0); st.k1 = *(const u32x4*)(Kg + (size_t)(r0 + 32) * ldk + c0);
    if (HASP) st.kp = *(const u32x4*)(Pg + (size_t)(tid >> 3) * 64 + (tid & 7) * 8);
    if (HASV) { st.v0 = *(const u32x4*)(Vg + (size_t)r0 * ldv + c0); st.v1 = *(const u32x4*)(Vg + (size_t)(r0 + 32) * ldv + c0); }
}
template <bool HASP, bool HASV>
__device__ __forceinline__ void stage_store(const Stage& st, LAS unsigned char* kbuf, LAS unsigned char* vbuf, int tid) {
    const int r0 = tid >> 4, c0 = (tid & 15) * 16;
    *(LAS u32x4*)(kbuf + r0 * KP + c0) = st.k0; *(LAS u32x4*)(kbuf + (r0 + 32) * KP + c0) = st.k1;
    if (HASP) *(LAS u32x4*)(kbuf + (tid >> 3) * KP + 256 + (tid & 7) * 16) = st.kp;
    if (HASV) { *(LAS u32x4*)(vbuf + r0 * VP + c0) = st.v0; *(LAS u32x4*)(vbuf + (r0 + 32) * VP + c0) = st.v1; }
}
__device__ __forceinline__ s16x4 vtr(const LAS unsigned char* p) { return __builtin_bit_cast(s16x4, __builtin_amdgcn_ds_read_tr16_b64_v4i16((LAS s16x4*)p)); }
__device__ __forceinline__ bf16x8 pack8(const f32x16& s, int o) {
    u32x4 w; w.x = cvtpk(s[o + 0], s[o + 1]); w.y = cvtpk(s[o + 2], s[o + 3]); w.z = cvtpk(s[o + 4], s[o + 5]); w.w = cvtpk(s[o + 6], s[o + 7]); return __builtin_bit_cast(bf16x8, w);
}

template <int MODE, int NQ>
__device__ __forceinline__ void run_seq(LAS unsigned char* lds, int tid, const bf16x8 (&qf)[NQ], f32x16 (&O)[4], float& m, float& l, const float C,
                                        const bf16_t* Kg, size_t ldk, const bf16_t* Pg, const bf16_t* Vg, size_t ldv,
                                        int jlo, int jhi, unsigned long long tmask, int hiB, int loB, unsigned long long mymask, int wmax, float inv_l, int tokl, int head) {
    constexpr bool HASP = (MODE == M_MLA), HASV = (MODE != M_CMP1);
    const int lane = tid & 63, hi = lane >> 5;
    const LAS unsigned char* kb_l = lds + OFF_K + (lane & 31) * KP + hi * 16;
    const LAS unsigned char* vb_l = lds + OFF_V + (4 * hi + ((lane & 15) >> 2)) * VP + (16 * ((lane >> 4) & 1) + 4 * (lane & 3)) * 2;
    int j; unsigned long long rem = 0ull;
    if (MODE == M_SEL) { rem = tmask; j = rem ? (int)__builtin_ctzll(rem) : -1; rem &= rem - 1ull; } else { j = jlo <= jhi ? jlo : -1; }
    Stage st;
    __syncthreads();
    if (j >= 0) stage_load<HASP, HASV>(st, Kg + (size_t)j * 64 * ldk, ldk, Pg + (size_t)j * 64 * 64, Vg + (size_t)j * 64 * ldv, ldv, tid);
    int it = 0;
    while (j >= 0) {
        const int bsel = it & 1;
        stage_store<HASP, HASV>(st, lds + OFF_K + bsel * KBUF, lds + OFF_V + bsel * VBUF, tid);
        __syncthreads();
        int jn;
        if (MODE == M_SEL) { jn = rem ? (int)__builtin_ctzll(rem) : -1; rem &= rem - 1ull; } else { jn = (j + 1 <= jhi) ? j + 1 : -1; }
        if (jn >= 0) stage_load<HASP, HASV>(st, Kg + (size_t)jn * 64 * ldk, ldk, Pg + (size_t)jn * 64 * 64, Vg + (size_t)jn * 64 * ldv, ldv, tid);
        const bool lvw = (MODE == M_SEL) ? (((mymask >> j) & 1ull) != 0ull) : true;
        if (!((MODE == M_MLA && 64 * j > wmax) || (MODE == M_SEL && !__any(lvw)))) {
            const LAS unsigned char* kb = kb_l + bsel * KBUF; const LAS unsigned char* vb = vb_l + bsel * VBUF;
            f32x16 s0, s1;
#pragma unroll
            for (int r = 0; r < 16; ++r) { s0[r] = 0.f; s1[r] = 0.f; }
            {
                constexpr int KW = (NQ == 8) ? 8 : ATT_KW12;
                bf16x8 kf[KW];
#pragma unroll
                for (int i = 0; i < KW; ++i) kf[i] = *(const LAS bf16x8*)(kb + (i & 1) * 32 * KP + (i >> 1) * 32);
                __builtin_amdgcn_sched_barrier(0);
#pragma unroll
                for (int i = 0; i < 2 * NQ; ++i) {
                    if (i & 1) s1 = __builtin_amdgcn_mfma_f32_32x32x16_bf16(kf[i % KW], qf[i >> 1], s1, 0, 0, 0);
                    else s0 = __builtin_amdgcn_mfma_f32_32x32x16_bf16(kf[i % KW], qf[i >> 1], s0, 0, 0, 0);
                    if (i + KW < 2 * NQ) { kf[i % KW] = *(const LAS bf16x8*)(kb + ((i + KW) & 1) * 32 * KP + ((i + KW) >> 1) * 32); __builtin_amdgcn_sched_barrier(0); }
                }
            }
            const int hl = hiB - 64 * j - 4 * hi, ll = loB - 64 * j - 4 * hi;
            const bool lv = lvw;
            bool need = true;
            if (MODE == M_WIN || MODE == M_MLA || MODE == M_SEL) need = __any(!((hl >= 63) && (ll < 0)));
            if (need) {
                const float NEG = -__builtin_inff();
#pragma unroll
                for (int r = 0; r < 16; ++r) { const int c = (r & 3) + 8 * (r >> 2);
                    if (!(lv && c <= hl && c > ll)) s0[r] = NEG;
                    if (!(lv && c + 32 <= hl && c + 32 > ll)) s1[r] = NEG; }
            }
            if (MODE == M_CMP2) {
#pragma unroll
                for (int r = 0; r < 16; ++r) { s0[r] = __builtin_amdgcn_exp2f(s0[r] * C - m) * inv_l; s1[r] = __builtin_amdgcn_exp2f(s1[r] * C - m) * inv_l; }
                LAS float* impG = (LAS float*)(lds + OFF_IMPG); LAS float* impL = (LAS float*)(lds + OFF_IMPL);
#pragma unroll
                for (int kb2 = 0; kb2 < 2; ++kb2)
#pragma unroll
                    for (int q4 = 0; q4 < 4; ++q4) {
                        const f32x16& sv = kb2 ? s1 : s0;
                        float gs = (sv[4 * q4] + sv[4 * q4 + 1]) + (sv[4 * q4 + 2] + sv[4 * q4 + 3]), ls = sv[4 * q4 + 3];
                        gs = quad_sum(gs); ls = quad_sum(ls);
                        const int jb = 16 * j + 8 * kb2 + 2 * q4 + hi;
                        if (head == 0) { impG[tokl * 64 + jb] = gs; if (jb + 1 < 64) impL[tokl * 64 + jb + 1] = ls; }
                    }
            } else {
                float mx = s0[0];
#pragma unroll
                for (int r = 1; r < 16; ++r) mx = fmaxf(mx, s0[r]);
#pragma unroll
                for (int r = 0; r < 16; ++r) mx = fmaxf(mx, s1[r]);
                mx = xhalf_max(mx);
                if (MODE == M_SEL) mx = lv ? mx : -__builtin_inff();
                const float mn = fmaxf(m, mx * C), alpha = __builtin_amdgcn_exp2f(m - mn);
                m = mn;
                float rs = 0.f;
#pragma unroll
                for (int r = 0; r < 16; ++r) { s0[r] = __builtin_amdgcn_exp2f(s0[r] * C - mn); s1[r] = __builtin_amdgcn_exp2f(s1[r] * C - mn); rs += s0[r] + s1[r]; }
                rs = xhalf_sum(rs);
                if (MODE == M_SEL) rs = lv ? rs : 0.f;
                l = l * alpha + rs;
                if (MODE != M_CMP1) {
                    if (!__all(alpha == 1.0f)) {
#pragma unroll
                        for (int db = 0; db < 4; ++db)
#pragma unroll
                            for (int r = 0; r < 16; ++r) O[db][r] *= alpha;
                    }
                }
            }
            if (MODE != M_CMP1) {
                bf16x8 pf[4]; pf[0] = pack8(s0, 0); pf[1] = pack8(s0, 8); pf[2] = pack8(s1, 0); pf[3] = pack8(s1, 8);
                if (MODE == M_SEL) { const bf16x8 z = {0, 0, 0, 0, 0, 0, 0, 0};
#pragma unroll
                    for (int i = 0; i < 4; ++i) pf[i] = lv ? pf[i] : z; }
#pragma unroll
                for (int ks = 0; ks < 4; ++ks)
#pragma unroll
                    for (int db = 0; db < 4; ++db) {
                        const s16x4 lo = vtr(vb + (16 * ks) * VP + db * 64), hv = vtr(vb + (16 * ks + 8) * VP + db * 64);
                        const bf16x8 vf = {lo[0], lo[1], lo[2], lo[3], hv[0], hv[1], hv[2], hv[3]};
                        O[db] = __builtin_amdgcn_mfma_f32_32x32x16_bf16(vf, pf[ks], O[db], 0, 0, 0);
                    }
            }
        }
        j = jn; ++it;
    }
}

__device__ __forceinline__ void zero_o(f32x16 (&O)[4]) {
#pragma unroll
    for (int db = 0; db < 4; ++db)
#pragma unroll
        for (int r = 0; r < 16; ++r) O[db][r] = 0.f;
}

__device__ __forceinline__ void nsa_unit(Frame& F, int b, int g, int c) {
    unsigned char* ws = F.ws; LAS unsigned char* lds = F.lds;
    int tid = F.tid; asm volatile("" : "+v"(tid));
    const int lane = tid & 63, w = __builtin_amdgcn_readfirstlane(tid >> 6), ql = lane & 31, hi = lane >> 5, head = ql & 3, tokl = 8 * w + (ql >> 2);
    const int ts = 64 * c + tokl; const size_t trow = (size_t)b * S + ts; const int hg = g * 4 + head;
    const float C = 0.08838834764831845f * LOG2E;
    const bf16_t* KV = (const bf16_t*)(ws + WS_KVNSA) + (size_t)b * S * 3072 + g * 128;
    bf16_t* accb = (bf16_t*)(ws + WS_NSAACC) + trow * 2048 + hg * 128;
    bf16x8 qf[8];
    { const bf16_t* qrow = (const bf16_t*)(ws + WS_QNSA) + trow * 2048 + hg * 128 + 8 * hi;
#pragma unroll
      for (int d = 0; d < 8; ++d) qf[d] = *(const bf16x8*)(qrow + 16 * d); }
    const float* gp = (const float*)(ws + WS_GATES) + trow * 48 + hg * 3; const float gc = gp[0], gs = gp[1], gw = gp[2];
    f32x16 O[4]; float m, l;
    {
        const bf16_t* KC = (const bf16_t*)(ws + WS_KC) + (size_t)(b * 4 + g) * 256 * 128; const bf16_t* VC = (const bf16_t*)(ws + WS_VC) + (size_t)(b * 4 + g) * 256 * 128;
        const int nct = (4 * c + 2) / 64 + 1, limc = (ts - 31) >> 4;
        m = -1e30f; l = 0.f; zero_o(O);
        run_seq<M_CMP1, 8>(lds, tid, qf, O, m, l, C, KC, 128, KC, VC, 128, 0, nct - 1, 0ull, limc, -1, 0ull, 0, 0.f, tokl, head);
        const float inv_l = l > 0.f ? 1.0f / l : 0.f;
        run_seq<M_CMP2, 8>(lds, tid, qf, O, m, l, C, KC, 128, KC, VC, 128, 0, nct - 1, 0ull, limc, -1, 0ull, 0, inv_l, tokl, head);
#pragma unroll
        for (int db = 0; db < 4; ++db)
#pragma unroll
            for (int q4 = 0; q4 < 4; ++q4) { f32x4 o = {O[db][4 * q4], O[db][4 * q4 + 1], O[db][4 * q4 + 2], O[db][4 * q4 + 3]}; *(u32x2*)(accb + 32 * db + 8 * q4 + 4 * hi) = pack4(o * gc); }
    }
    __syncthreads();
    {
        LAS unsigned long long* selm = (LAS unsigned long long*)(lds + OFF_SELM); LAS unsigned long long* uni = (LAS unsigned long long*)(lds + OFF_UNI);
        const LAS float* impG = (const LAS float*)(lds + OFF_IMPG); const LAS float* impL = (const LAS float*)(lds + OFF_IMPL);
        unsigned long long wuni = 0ull;
        for (int tt = 0; tt < 8; ++tt) {
            const int tl = 8 * w + tt; unsigned long long mk;
            if (c >= 16) {
                const bool cand = (lane >= 1) && (lane <= c - 2);
                const float v = cand ? impG[tl * 64 + lane] + impL[tl * 64 + lane] : -__builtin_inff();
                int rank = 0;
                for (int i = 0; i < 64; ++i) { const float vi = rdlane(v, i); rank += ((vi > v) || (vi == v && i < lane)) ? 1 : 0; }
                mk = __ballot(cand && rank < 13) | 1ull | (1ull << c) | (1ull << (c - 1));
            } else mk = (2ull << c) - 1ull;
            if (lane == 0) selm[tl] = mk;
            wuni |= mk;
        }
        if (lane == 0) uni[w] = wuni;
    }
    __syncthreads();
    unsigned long long mymask, tmask = 0ull;
    { const LAS unsigned long long* selm = (const LAS unsigned long long*)(lds + OFF_SELM); const LAS unsigned long long* uni = (const LAS unsigned long long*)(lds + OFF_UNI);
      mymask = selm[tokl];
#pragma unroll
      for (int i = 0; i < 8; ++i) tmask |= uni[i];
      tmask &= (2ull << c) - 1ull;
      tmask = ((unsigned long long)(unsigned)__builtin_amdgcn_readfirstlane((int)(unsigned)(tmask >> 32)) << 32) | (unsigned long long)(unsigned)__builtin_amdgcn_readfirstlane((int)(unsigned)tmask); }
    m = -1e30f; l = 0.f; zero_o(O);
    run_seq<M_SEL, 8>(lds, tid, qf, O, m, l, C, KV + 2 * 512, 3072, KV, KV + 3 * 512, 3072, 0, c, tmask, ts, -1, mymask, 0, 0.f, tokl, head);
    { const float sc = l > 0.f ? gs / l : 0.f;
#pragma unroll
      for (int db = 0; db < 4; ++db)
#pragma unroll
          for (int q4 = 0; q4 < 4; ++q4) { bf16_t* p = accb + 32 * db + 8 * q4 + 4 * hi; f32x4 o = {O[db][4 * q4], O[db][4 * q4 + 1], O[db][4 * q4 + 2], O[db][4 * q4 + 3]}; const u32x2 w = *(const u32x2*)p;
              const f32x4 pr = {__uint_as_float(w.x << 16), __uint_as_float(w.x & 0xffff0000u), __uint_as_float(w.y << 16), __uint_as_float(w.y & 0xffff0000u)}; *(u32x2*)p = pack4(pr + o * sc); } }
    m = -1e30f; l = 0.f; zero_o(O);
    run_seq<M_WIN, 8>(lds, tid, qf, O, m, l, C, KV + 4 * 512, 3072, KV, KV + 5 * 512, 3072, c >= 8 ? c - 8 : 0, c, 0ull, ts, ts - 512, 0ull, 0, 0.f, tokl, head);
    { const float sc = l > 0.f ? gw / l : 0.f; unsigned char* orow = ws + WS_H + ((((trow >> 8) * 32) + hg) * 256 + (trow & 255)) * 128;
#pragma unroll
      for (int db = 0; db < 4; ++db)
#pragma unroll
          for (int q4 = 0; q4 < 4; ++q4) { const bf16_t* p = accb + 32 * db + 8 * q4 + 4 * hi; f32x4 o = {O[db][4 * q4], O[db][4 * q4 + 1], O[db][4 * q4 + 2], O[db][4 * q4 + 3]}; const u32x2 w = *(const u32x2*)p;
              const f32x4 pr = {__uint_as_float(w.x << 16), __uint_as_float(w.x & 0xffff0000u), __uint_as_float(w.y << 16), __uint_as_float(w.y & 0xffff0000u)};
              const f32x4 r = pr + o * sc;
              if constexpr (FP8_OUT) *(unsigned*)(orow + 32 * db + 8 * q4 + 4 * hi) = pack4_fp8(r[0] * 16.0f, r[1] * 16.0f, r[2] * 16.0f, r[3] * 16.0f);
              else *(u32x2*)((bf16_t*)(ws + WS_H) + trow * 4096 + hg * 128 + 32 * db + 8 * q4 + 4 * hi) = pack4(r); } }
}

__device__ __forceinline__ void mla_unit(Frame& F, int b, int hd, int qb) {
    unsigned char* ws = F.ws; LAS unsigned char* lds = F.lds;
    int tid = F.tid; asm volatile("" : "+v"(tid));
    const int lane = tid & 63, w = __builtin_amdgcn_readfirstlane(tid >> 6), ql = lane & 31, hi = lane >> 5;
    const int ts = 256 * qb + 32 * w + ql; const size_t trow = (size_t)b * S + ts;
    const float C = 0.07216878364870322f * LOG2E;
    bf16x8 qf[12];
    { const bf16_t* qrow = (const bf16_t*)(ws + WS_QMLA) + trow * 3072 + hd * 192 + 8 * hi;
#pragma unroll
      for (int d = 0; d < 12; ++d) qf[d] = *(const bf16x8*)(qrow + 16 * d); }
    const bf16_t* KN = (const bf16_t*)(ws + WS_KN) + (size_t)b * S * 2048 + hd * 128; const bf16_t* VM = (const bf16_t*)(ws + WS_VM) + (size_t)b * S * 2048 + hd * 128;
    const bf16_t* KPE = (const bf16_t*)(ws + WS_KPE) + (size_t)b * S * 64;
    f32x16 O[4]; float m = -1e30f, l = 0.f; zero_o(O);
    run_seq<M_MLA, 12>(lds, tid, qf, O, m, l, C, KN, 2048, KPE, VM, 2048, 0, 4 * qb + 3, 0ull, ts, -1, 0ull, 256 * qb + 32 * w + 31, 0.f, 0, 0);
    const float sc = l > 0.f ? (FP8_OUT ? 16.0f : 1.0f) / l : 0.f; unsigned char* orow = ws + WS_H + ((((trow >> 8) * 32) + 16 + hd) * 256 + (trow & 255)) * 128;
#pragma unroll
    for (int db = 0; db < 4; ++db)
#pragma unroll
        for (int q4 = 0; q4 < 4; ++q4) {
            if constexpr (FP8_OUT) *(unsigned*)(orow + 32 * db + 8 * q4 + 4 * hi) = pack4_fp8(O[db][4 * q4] * sc, O[db][4 * q4 + 1] * sc, O[db][4 * q4 + 2] * sc, O[db][4 * q4 + 3] * sc);
            else { f32x4 o = {O[db][4 * q4], O[db][4 * q4 + 1], O[db][4 * q4 + 2], O[db][4 * q4 + 3]}; *(u32x2*)((bf16_t*)(ws + WS_H) + trow * 4096 + 2048 + hd * 128 + 32 * db + 8 * q4 + 4 * hi) = pack4(o * sc); } }
}
}

struct Args { const void* in[23]; float* out; unsigned char* ws; int ph_lo, ph_hi; };
static_assert(sizeof(Args) == 23 * 8 + 8 + 8 + 8, "Args has no padding");

__global__ void __launch_bounds__(512, 2) fwd(Args args) {
    extern __shared__ __attribute__((aligned(16))) unsigned char lds_raw[];
    Frame F;
    F.lds = (LAS unsigned char*)lds_raw;
    F.MISC = (volatile LAS unsigned*)(F.lds + MISC_OFF);
    F.tid = threadIdx.x; F.lane = F.tid & 63; F.wave = __builtin_amdgcn_readfirstlane(F.tid >> 6);
    F.G = gridDim.x; { const int bx = blockIdx.x; F.vcu = (F.G % 8 == 0) ? (bx % 8) * (F.G / 8) + bx / 8 : bx; }
    F.ws = args.ws; F.out = args.out;
    F.x = (const float*)args.in[0]; F.c = (const float*)args.in[1]; F.positions = (const int*)args.in[2]; F.w_ada = (const float*)args.in[3]; F.b_ada = (const float*)args.in[4];
    F.w_in = (const float*)args.in[5]; F.pos_k = (const float*)args.in[6]; F.pos_v = (const float*)args.in[7]; F.k1 = (const float*)args.in[8]; F.k2 = (const float*)args.in[9];
    F.v1 = (const float*)args.in[10]; F.v2 = (const float*)args.in[11]; F.qn = (const float*)args.in[12]; F.kvn = (const float*)args.in[13]; F.w_uq = (const float*)args.in[14];
    F.w_ukv = (const float*)args.in[15]; F.w_out = (const float*)args.in[16]; F.ln1g = (const float*)args.in[17]; F.ln1b = (const float*)args.in[18]; F.w_ff1 = (const float*)args.in[19];
    F.w_ff2 = (const float*)args.in[20]; F.ln2g = (const float*)args.in[21]; F.ln2b = (const float*)args.in[22];
    unsigned char* ws = args.ws;
    for (int u = F.tid; u < (LDS_BYTES - LDSCTL_OFF) / 4; u += 512) ((LAS unsigned*)(F.lds + LDSCTL_OFF))[u] = 0u;
    __syncthreads();
    XcdBarrier bar; bar.bar = (unsigned*)(ws + WS_CTL) + CW_BAR; bar.x = 0; bar.st = nullptr;
    if (N_LAUNCHES == 1) bar = xcd_barrier_post((unsigned*)(ws + WS_CTL) + CW_BAR, F.MISC + 8);
    const int lo = args.ph_lo, hi = args.ph_hi;
#ifndef PH_MASK
#define PH_MASK 0x3ff
#endif
#ifndef REP_MASK
#define REP_MASK 0
#endif
#define NREP(k) (((REP_MASK >> (k)) & 1) ? 2 : 1)
#define IN(k) (((PH_MASK >> (k)) & 1) && lo <= (k) && (k) < hi)
#define SEAM(k) do { if (IN(k) && IN((k) + 1)) xcd_barrier(bar); } while (0)
    const float* modf = (const float*)(ws + WS_MODF);
    bf16_t* H = (bf16_t*)(ws + WS_H);

    if (IN(0)) { for (int rep = 0; rep < NREP(0); ++rep) { p0_prologue(F); __syncthreads(); } } SEAM(0);
    if (IN(1)) { for (int rep = 0; rep < NREP(1); ++rep) p1_modulate(F); } SEAM(1);
    if (IN(2)) {
        static_assert(FP8_IN && FP8_OUT, "the K-tile-blocked A images are written as e4m3"); pg8::GBlkA g{H, (const bf16_t*)(ws + WS_WINT), 128u, D * 1u, D / 2}; pg8::StaticOrder So; So.init(T, 7168, F.G, (int)blockIdx.x);
        pg8::EpiInProj E{(bf16_t*)(ws + WS_QNSA), (bf16_t*)(ws + WS_KVNSA), (bf16_t*)(ws + WS_CQ), (bf16_t*)(ws + WS_CKV), (float*)(ws + WS_RSSQ), (float*)(ws + WS_RSSKV), (const float*)(ws + WS_ROPEP)};
        pg8::gemm_phase<pg8::GBlkA, pg8::EpiInProj, pg8::StaticOrder, FP8_IN, 0x79797979, 0x7f7f7f7f, FF1_ALIGN>(F.lds, g, So, E);
    } SEAM(2);
    if (IN(3)) {
        const int m8 = F.vcu & 7, a8 = F.vcu >> 3;
        {
            pg8::GCmp1 g{(const bf16_t*)(ws + WS_KVNSA), (const bf16_t*)(ws + WS_K1T), (const bf16_t*)(ws + WS_V1T), 16u * 3072u * 2u, 4096u * 2u, 4096};
            pg8::RangeOrder So{a8, m8 == 0 ? 1 : 0, 1};
            pg8::EpiCmpHid E{(bf16_t*)(ws + WS_HIDK), (bf16_t*)(ws + WS_HIDV), (const float*)(ws + WS_SMALL)};
            pg8::gemm_phase(F.lds, g, So, E);
            asm volatile("s_waitcnt vmcnt(0)" ::: "memory"); __builtin_amdgcn_fence(__ATOMIC_RELEASE, "workgroup"); __syncthreads(); __builtin_amdgcn_fence(__ATOMIC_ACQUIRE, "agent"); asm volatile("s_waitcnt vmcnt(0)" ::: "memory");
            pg8::GCmp2 g2{(const bf16_t*)(ws + WS_HIDK), (const bf16_t*)(ws + WS_HIDV), (const bf16_t*)(ws + WS_SMALL + 65536), (const bf16_t*)(ws + WS_SMALL + 196608), 256u * 2u, 256u * 2u, 256};
            pg8::EpiCmpOut E2{(bf16_t*)(ws + WS_KC), (bf16_t*)(ws + WS_VC)};
            pg8::gemm_phase(F.lds, g2, So, E2);
        }
        {
            pg8::GBlkA g{H, (const bf16_t*)(ws + WS_WINT + (size_t)7168 * D), 128u, D * 1u, D / 2};
            pg8::RangeOrder So{2 * a8 + m8 - 1, (m8 == 1 || m8 == 2) ? 1 : 0, 1};
            pg8::EpiMisc E{(bf16_t*)(ws + WS_KPE), (float*)(ws + WS_GATES), (const float*)(ws + WS_ROPEM)};
            pg8::gemm_phase<pg8::GBlkA, pg8::EpiMisc, pg8::RangeOrder, FP8_IN, 0x79797979, 0x7f7f7f7f>(F.lds, g, So, E);
        }
        const int nq = (int)((0x0304040404020201ull >> (8 * m8)) & 0xff), pq = (int)((0x15110d0905030100ull >> (8 * m8)) & 0xff);
        const int nkv = (int)((0x0504040404040403ull >> (8 * m8)) & 0xff), pkv = (int)((0x1b17130f0b070300ull >> (8 * m8)) & 0xff);
        LAS float* rfq = (LAS float*)(F.lds + RING_BYTES + 4096); LAS float* rfkv = rfq + 512;
        {   const int row = 512 * a8 + F.tid;
            const f32x4* pq4 = (const f32x4*)((const float*)(ws + WS_RSSQ) + (size_t)row * 24); f32x4 sq = pq4[0];
#pragma unroll
            for (int i = 1; i < 6; ++i) sq += pq4[i];
            const f32x4* pk4 = (const f32x4*)((const float*)(ws + WS_RSSKV) + (size_t)row * 8); const f32x4 sk = pk4[0] + pk4[1];
            rfq[F.tid] = 1.0f / sqrtf(((sq[0] + sq[1]) + (sq[2] + sq[3])) * (1.0f / QR) + 1e-6f);
            rfkv[F.tid] = 1.0f / sqrtf(((sk[0] + sk[1]) + (sk[2] + sk[3])) * (1.0f / KVR) + 1e-6f);
            __syncthreads(); }
        {
            pg8::GLin g{(const bf16_t*)(ws + WS_CQ), (const bf16_t*)(ws + WS_WUQT), FP8_UP ? QR * 1u : QR * 2u, FP8_UP ? QR * 1u : QR * 2u, FP8_UP ? QR / 2 : QR}; pg8::RangeOrder So{24 * a8 + pq, nq, 12};
            pg8::EpiQUp E{(bf16_t*)(ws + WS_QMLA), rfq, 512 * a8, (const float*)(ws + WS_ROPEM)};
            pg8::gemm_phase<pg8::GLin, pg8::EpiQUp, pg8::RangeOrder, FP8_UP, 0x7a7a7a7a, 0x7f7f7f7f>(F.lds, g, So, E);
        }
        {
            pg8::GLin g{(const bf16_t*)(ws + WS_CKV), (const bf16_t*)(ws + WS_WUKVT), FP8_UP ? KVR * 1u : KVR * 2u, FP8_UP ? KVR * 1u : KVR * 2u, FP8_UP ? KVR / 2 : KVR}; pg8::RangeOrder So{32 * a8 + pkv, nkv, 16};
            pg8::EpiKVUp E{(bf16_t*)(ws + WS_KN), (bf16_t*)(ws + WS_VM), rfkv, 512 * a8};
            pg8::gemm_phase<pg8::GLin, pg8::EpiKVUp, pg8::RangeOrder, FP8_UP, 0x7b7b7b7b, 0x7f7f7f7f>(F.lds, g, So, E);
        }
    } SEAM(3);
    if (IN(4)) {
        if (F.wave >= 4) __builtin_amdgcn_s_setprio(1);
        for (int rep = 0; rep < NREP(11); ++rep)
        for (int item = F.vcu; item < 512; item += F.G) { const int bg = item >> 5, p = item & 31;

            for (int h2 = 0; h2 < 2; ++h2) att::nsa_unit(F, bg >> 2, bg & 3, h2 ? p : 63 - p); }
        for (int rep = 0; rep < NREP(12); ++rep)
        for (int item = F.vcu; item < 512; item += F.G) { const int bh = item >> 3, p = item & 7;

            for (int h2 = 0; h2 < 2; ++h2) att::mla_unit(F, bh >> 4, bh & 15, h2 ? p : 15 - p); }
        __builtin_amdgcn_s_setprio(0);
        __syncthreads();
    } SEAM(4);
    if (IN(5)) for (int rep = 0; rep < NREP(5); ++rep) {
        pg8::GBlkA g{H, (const bf16_t*)(ws + WS_WOUTT), 128u, D * 1u, D / 2}; pg8::StaticOrder So; So.init(T, D, F.G, (int)blockIdx.x);
        pg8::EpiY1 E{F.x, (bf16_t*)(ws + WS_Y1), modf + 2 * D};
        pg8::gemm_phase<pg8::GBlkA, pg8::EpiY1, pg8::StaticOrder, FP8_OUT, 0x79797979, 0x7b7b7b7b, FF1_ALIGN>(F.lds, g, So, E);
    } SEAM(5);
    if (IN(6)) { ln1_phase(F, modf); } SEAM(6);
    if (IN(7)) for (int rep = 0; rep < NREP(7); ++rep) {
        pg8::GBlkA g{H, (const bf16_t*)(ws + WS_WFF1T), 128u, D * 2u, D}; pg8::StaticOrder So; So.init(T, DFF, F.G, (int)blockIdx.x);
        pg8::EpiRelu2 E{(bf16_t*)(ws + WS_FFH)};
        pg8::gemm_phase<pg8::GBlkA, pg8::EpiRelu2, pg8::StaticOrder, false, 0x7f7f7f7f, 0x7f7f7f7f, FF1_ALIGN>(F.lds, g, So, E);
    } SEAM(7);
    if (IN(8)) {
        pg8::GBlkAS g{(const bf16_t*)(ws + WS_FFH), (const bf16_t*)(ws + WS_WFF2T), 128u, DFF * 2u, DFF, FFH_PSTRIDE}; pg8::StaticOrder So; So.init(T, D, F.G, (int)blockIdx.x, FF2_WGM);
        pg8::EpiY2 E{(const bf16_t*)(ws + WS_Y1), (bf16_t*)(ws + WS_H), modf + 5 * D, (const float*)(ws + WS_STATS), F.ln1g, F.ln1b};
        pg8::gemm_phase<pg8::GBlkAS, pg8::EpiY2, pg8::StaticOrder, false, 0x7f7f7f7f, 0x7f7f7f7f, FF1_ALIGN>(F.lds, g, So, E);
    } SEAM(8);
    if (IN(9)) { ln2_phase(F); }
#undef IN
#undef SEAM
}

extern "C" void kernel_launch(void* const* d_in, const int* in_sizes, int n_in, void* d_out, int out_size, void* d_ws, size_t ws_size, hipStream_t stream) {
    static int grid = 0;
    if (grid == 0) {
        if (n_in != 23 || in_sizes[0] != T * D || out_size != T * D || ws_size < WS_END) { fprintf(stderr, "kernel_launch: unexpected shapes (n_in %d, in0 %d, out %d, ws %zu)\n", n_in, n_in > 0 ? in_sizes[0] : -1, out_size, ws_size); grid = -1; return; }
        int dev = 0, cus = 0, per_cu = 0;
        if (hipGetDevice(&dev) != hipSuccess || hipDeviceGetAttribute(&cus, hipDeviceAttributeMultiprocessorCount, dev) != hipSuccess) { grid = -1; return; }
        if (hipFuncSetAttribute((const void*)fwd, hipFuncAttributeMaxDynamicSharedMemorySize, LDS_BYTES) != hipSuccess) { fprintf(stderr, "kernel_launch: hipFuncSetAttribute failed\n"); grid = -1; return; }
        if (hipOccupancyMaxActiveBlocksPerMultiprocessor(&per_cu, (const void*)fwd, 512, LDS_BYTES) != hipSuccess || per_cu < 1) fprintf(stderr, "kernel_launch: occupancy query reports %d\n", per_cu);
        (void)hipGetLastError();
        if (cus < 256) { fprintf(stderr, "kernel_launch: %d CUs; this kernel is laid out for 256 resident workgroups\n", cus); grid = -1; return; }
        grid = 256;
    }
    if (grid < 0) return;
    if (hipMemsetAsync((char*)d_ws + WS_CTL, 0, CTL_ZERO_BYTES, stream) != hipSuccess) return;
    Args a{};
    for (int i = 0; i < 23; ++i) a.in[i] = d_in[i];
    a.out = (float*)d_out; a.ws = (unsigned char*)d_ws;
    for (int li = 0; li < N_LAUNCHES; ++li) {
        a.ph_lo = (N_LAUNCHES == 1) ? 0 : li; a.ph_hi = (N_LAUNCHES == 1) ? NPHASE : li + 1;
        hipLaunchKernelGGL(fwd, dim3(grid), dim3(512), LDS_BYTES, stream, a);
        const hipError_t le = hipPeekAtLastError();
        if (le != hipSuccess) { fprintf(stderr, "kernel_launch: launch %d failed: %s\n", li, hipGetErrorName(le)); break; }
    }
}
```

```cpp
#include <hip/hip_runtime.h>
#include <cstdio>
#include <cstdint>

#define LAS __attribute__((address_space(3)))
#define GAS __attribute__((address_space(1)))
typedef unsigned short bf16_t;
typedef short bf16x8 __attribute__((ext_vector_type(8)));
typedef short s16x4 __attribute__((ext_vector_type(4)));
typedef float f32x2 __attribute__((ext_vector_type(2)));
typedef float f32x4 __attribute__((ext_vector_type(4)));
typedef float f32x16 __attribute__((ext_vector_type(16)));
typedef unsigned u32x2 __attribute__((ext_vector_type(2)));
typedef unsigned u32x4 __attribute__((ext_vector_type(4)));
typedef __bf16 bf16x2_t __attribute__((ext_vector_type(2)));

#ifndef MK_N_LAUNCHES
#define MK_N_LAUNCHES 1
#endif
constexpr int NPHASE = 10;
#ifndef FP8_IN_
#define FP8_IN_ 1
#endif
#ifndef FP8_OUT_
#define FP8_OUT_ 1
#endif
#ifndef FP8_UP_
#define FP8_UP_ 1
#endif
constexpr bool FP8_UP = FP8_UP_ != 0;
constexpr bool FP8_IN = FP8_IN_ != 0, FP8_OUT = FP8_OUT_ != 0;
constexpr int N_LAUNCHES = MK_N_LAUNCHES;

constexpr int NB = 4, S = 4096, D = 4096, T = NB * S;
constexpr int DINP = 7424;
constexpr int DFF = 16384;
constexpr int NADA = 6 * D;
constexpr int QR = 1536, KVR = 512;
constexpr float ALPHA = 1.189207115002721f;
constexpr float LOG2E = 1.4426950408889634f;
constexpr int ADA_KCH = 16;

constexpr size_t MiB = 1u << 20;
constexpr size_t WS_CTL = 0, CTL_ZERO_BYTES = 1 * MiB;
constexpr size_t WS_MODP = 1 * MiB;
constexpr size_t WS_MODF = 7 * MiB;
constexpr size_t WS_ROPEP = 8 * MiB;
constexpr size_t WS_ROPEM = 10 * MiB;
constexpr size_t WS_SMALL = 14 * MiB;
constexpr size_t WS_K1T = 15 * MiB, WS_V1T = 17 * MiB;
constexpr size_t WS_WINT = 19 * MiB;
constexpr size_t WS_WUQT = 77 * MiB;
constexpr size_t WS_WUKVT = 86 * MiB;
constexpr size_t WS_WOUTT = 90 * MiB;
constexpr size_t WS_WFF1T = 122 * MiB;
constexpr size_t WS_WFF2T = 250 * MiB;
constexpr size_t WS_H = 378 * MiB;
constexpr size_t WS_QNSA = 506 * MiB;
constexpr size_t WS_KVNSA = 570 * MiB;
constexpr size_t WS_CQ = 666 * MiB;
constexpr size_t WS_CKV = 714 * MiB;
constexpr size_t WS_KPE = 730 * MiB;
constexpr size_t WS_GATES = 732 * MiB;
constexpr size_t WS_RSSQ = 735 * MiB;
constexpr size_t WS_RSSKV = 737 * MiB;
constexpr size_t WS_HIDK = 738 * MiB, WS_HIDV = 740 * MiB;
constexpr size_t WS_KC = 742 * MiB, WS_VC = 743 * MiB;
constexpr size_t WS_QMLA = 744 * MiB;
constexpr size_t WS_KN = 840 * MiB;
constexpr size_t WS_VM = 904 * MiB;
constexpr size_t WS_NSAACC = 968 * MiB;
constexpr size_t WS_FFH = 506 * MiB;
constexpr size_t WS_Y1 = 1100 * MiB;
constexpr size_t WS_STATS = 1230 * MiB;
constexpr size_t WS_END = 1232 * MiB;
#ifndef FF1_ALIGN
#define FF1_ALIGN false
#endif
#ifndef ATT_KW12
#define ATT_KW12 12
#endif
#ifndef FF2_WGM
#define FF2_WGM 4
#endif
constexpr int CW_BAR = 4096;

constexpr int RING_BYTES = 131072;
constexpr int LDSCTL_OFF = RING_BYTES, MISC_OFF = LDSCTL_OFF + 320;
constexpr int LDS_BYTES = 147456;

__device__ __forceinline__ unsigned cvtpk(float lo, float hi) { f32x2 v = {lo, hi}; bf16x2_t b = __builtin_convertvector(v, bf16x2_t); return __builtin_bit_cast(unsigned, b); }
__device__ __forceinline__ u32x2 pack4(f32x4 v) { u32x2 w; w.x = cvtpk(v[0], v[1]); w.y = cvtpk(v[2], v[3]); return w; }
__device__ __forceinline__ unsigned pack4_fp8(float a, float b, float c, float d) { unsigned w = 0u; w = (unsigned)__builtin_amdgcn_cvt_pk_fp8_f32(a, b, (int)w, false); w = (unsigned)__builtin_amdgcn_cvt_pk_fp8_f32(c, d, (int)w, true); return w; }
__device__ __forceinline__ float wave_sum(float v) {
#pragma unroll
    for (int o = 1; o < 64; o <<= 1) v += __shfl_xor(v, o);
    return v;
}
__device__ __forceinline__ float xhalf_max(float x) { const auto r = __builtin_amdgcn_permlane32_swap(__float_as_uint(x), __float_as_uint(x), false, false); return fmaxf(__uint_as_float(r[0]), __uint_as_float(r[1])); }
__device__ __forceinline__ float xhalf_sum(float x) { const auto r = __builtin_amdgcn_permlane32_swap(__float_as_uint(x), __float_as_uint(x), false, false); return __uint_as_float(r[0]) + __uint_as_float(r[1]); }
__device__ __forceinline__ float quad_sum(float x) {
    x += __int_as_float(__builtin_amdgcn_mov_dpp(__float_as_int(x), 0xB1, 0xf, 0xf, true));
    x += __int_as_float(__builtin_amdgcn_mov_dpp(__float_as_int(x), 0x4E, 0xf, 0xf, true));
    return x; }
__device__ __forceinline__ float rdlane(float v, int l) { return __int_as_float(__builtin_amdgcn_readlane(__float_as_int(v), l)); }

namespace pg8 {
constexpr int BM = 256, BK = 64, HALF = 128, HTB = HALF * BK * 2, STAGE_BYTES = 8 * HTB, NXCD = 8, WGM = 8;
__host__ __device__ __forceinline__ int lds_byte(int r, int c) { const int st = (r >> 4) * 2 + (c >> 5), rr = r & 15, cc = c & 31, ob = rr * 64 + cc * 2; return st * 1024 + (ob ^ (((ob >> 9) & 1) << 5)); }
__host__ __device__ __forceinline__ void stage_rc(int b, int& R, int& C) { const int st = b / 1024, sb = b % 1024, swz = sb ^ (((sb >> 9) & 1) << 5); R = (st >> 1) * 16 + swz / 64; C = (st & 1) * 32 + (swz % 64) / 2; }
__host__ __device__ __forceinline__ int perm32(int rho) { const int n = rho >> 4, i = rho & 15; return 8 * (i >> 2) + 4 * n + (i & 3); }

struct Unit { int pm, pn; };

struct GLin {
    const bf16_t* A; const bf16_t* Bt; unsigned lda2, ldb2; int K;
    __device__ __forceinline__ const char* a_tile(const Unit& u) const { return (const char*)A + (size_t)u.pm * 256 * lda2; }
    __device__ __forceinline__ const char* b_tile(const Unit& u) const { return (const char*)Bt + (size_t)u.pn * 256 * ldb2; }
    __device__ __forceinline__ size_t a_koff(int t) const { return (size_t)t * 128; }
};

struct GBlkA {
    const bf16_t* A; const bf16_t* Bt; unsigned lda2, ldb2; int K;
    __device__ __forceinline__ const char* a_tile(const Unit& u) const { return (const char*)A + (size_t)u.pm * (size_t)(K / 64) * 32768; }
    __device__ __forceinline__ const char* b_tile(const Unit& u) const { return (const char*)Bt + (size_t)u.pn * 256 * ldb2; }
    __device__ __forceinline__ size_t a_koff(int t) const { return (size_t)t * 32768; }
};

struct StaticOrder {
    int nM, nN, nwg, G, c, wgm;
    __device__ void init(int M, int N, int G_, int c_, int wgm_ = WGM) { nM = M / BM; nN = N / BM; nwg = nM * nN; G = G_; c = c_; wgm = wgm_; }
    __device__ bool next(int i, Unit& u) const {
        const long L = (long)i * G + c; if (L >= nwg) return false;
        int wgid = (int)L; { const int q = nwg / NXCD, r = nwg % NXCD, xcd = wgid % NXCD, off = wgid / NXCD; wgid = (xcd < r ? xcd * (q + 1) : r * (q + 1) + (xcd - r) * q) + off; }
        const int nig = wgm * nN, gid = wgid / nig, fm = gid * wgm, gsz = (nM - fm) < wgm ? (nM - fm) : wgm;
        u.pm = fm + ((wgid % nig) % gsz); u.pn = (wgid % nig) / gsz; return true;
    }
};
struct ListOrder {
    int n, G, c;
    __device__ bool next(int i, Unit& u) const { const int L = i * G + c; if (L >= n) return false; u.pm = L; u.pn = 0; return true; }
};

struct RangeOrder {
    int start, cnt, nN;
    __device__ bool next(int i, Unit& u) const { if (i >= cnt) return false; const int L = start + i; u.pm = L / nN; u.pn = L - u.pm * nN; return true; }
};

typedef int i32x4 __attribute__((ext_vector_type(4)));
typedef int i32x8 __attribute__((ext_vector_type(8)));
__device__ __forceinline__ i32x8 cat8(bf16x8 lo, bf16x8 hi) { const i32x4 a = __builtin_bit_cast(i32x4, lo), b = __builtin_bit_cast(i32x4, hi); return __builtin_shufflevector(a, b, 0, 1, 2, 3, 4, 5, 6, 7); }
template <class GD, class Epi, class Sched, bool F8 = false, int SCALE_W = 0x7f7f7f7f, int SCALE_A = 0x7f7f7f7f, bool ALIGN = true>
__device__ __forceinline__ void gemm_phase(LAS unsigned char* lds, const GD g, const Sched& S, const Epi& E) {
    const int tid = threadIdx.x, wid = __builtin_amdgcn_readfirstlane(tid >> 6), lane = tid & 63, wr = wid >> 2, wc = wid & 3, fr = lane & 15, fq = lane >> 4;
    const int K = g.K, nt = K / BK;
    unsigned voffA, voffB;
    { int R, C; stage_rc(tid * 16, R, C); const int Rb = Epi::PERM ? ((R & ~31) + perm32(R & 31)) : R;
      voffA = (unsigned)R * g.lda2 + (unsigned)C * 2u; voffB = (unsigned)Rb * g.ldb2 + (unsigned)C * 2u; }
    const size_t pvoffA = (size_t)64 * g.lda2, pvoffB = (size_t)64 * g.ldb2;
    const size_t kstep = (size_t)(BK * 2);
    const size_t hstepA = (size_t)HALF * g.lda2, hstepB = (size_t)HALF * g.ldb2;
    const unsigned ldsw = (unsigned)wid * 1024u;
    const int aoff = lds_byte(wr * 64 + fr, fq * 8), boff = lds_byte(wc * 32 + fr, fq * 8);
#define PG8_SA(b, h) (((b) * 2 + (h)) * HTB)
#define PG8_SB(b, h) ((4 + (b) * 2 + (h)) * HTB)
#define PG8_STAGE(bufoff, gbase, voff) do { _Pragma("unroll") for (int _i = 0; _i < 2; ++_i) \
        __builtin_amdgcn_global_load_lds((const unsigned*)((const char*)(gbase) + (size_t)_i * p##voff + (voff)), (LAS unsigned*)(lds + (bufoff) + ldsw + _i * 8192), 16, 0, 0); } while (0)
#define PG8_LDA(dst, b, h) do { _Pragma("unroll") for (int m = 0; m < 4; ++m) _Pragma("unroll") for (int k = 0; k < 2; ++k) dst[m][k] = *(const LAS bf16x8*)(lds + PG8_SA(b, h) + aoff + m * 2048 + k * 1024); } while (0)
#define PG8_LDB(dst, b, h) do { _Pragma("unroll") for (int n = 0; n < 2; ++n) _Pragma("unroll") for (int k = 0; k < 2; ++k) dst[n][k] = *(const LAS bf16x8*)(lds + PG8_SB(b, h) + boff + n * 2048 + k * 1024); } while (0)
#define PG8_MMA(ai, bj, At, Bt) do { __builtin_amdgcn_s_setprio(1); _Pragma("unroll") for (int m = 0; m < 4; ++m) _Pragma("unroll") for (int n = 0; n < 2; ++n) { \
        if constexpr (F8) { const i32x8 _b8 = cat8(Bt[n][0], Bt[n][1]), _a8 = cat8(At[m][0], At[m][1]); \
            asm volatile("v_mfma_scale_f32_16x16x128_f8f6f4 %0, %1, %2, %0, %3, %4 op_sel_hi:[0,0,0]" : "+v"(acc[ai][bj][m][n]) : "v"(_b8), "v"(_a8), "v"(scw), "v"(sca)); } \
        else { _Pragma("unroll") for (int k = 0; k < 2; ++k) acc[ai][bj][m][n] = __builtin_amdgcn_mfma_f32_16x16x32_bf16(Bt[n][k], At[m][k], acc[ai][bj][m][n], 0, 0, 0); } } \
        __builtin_amdgcn_s_setprio(0); } while (0)
#define PG8_WAIT_V(n) asm volatile("s_waitcnt vmcnt(" #n ")" ::: "memory")
#define PG8_WAIT_L(n) asm volatile("s_waitcnt lgkmcnt(" #n ")" ::: "memory")
#define PG8_BAR __builtin_amdgcn_s_barrier()
#define PG8_SCHED __builtin_amdgcn_sched_barrier(0)
    Unit cur, nxt; int ui = 0;
    if (!S.next(0, cur)) return;
    const int scw = SCALE_W, sca = SCALE_A;
    f32x4 acc[2][2][4][2];
#pragma unroll
    for (int a = 0; a < 2; ++a)
#pragma unroll
        for (int b = 0; b < 2; ++b)
#pragma unroll
            for (int m = 0; m < 4; ++m)
#pragma unroll
                for (int n = 0; n < 2; ++n) acc[a][b][m][n] = (f32x4){0.f, 0.f, 0.f, 0.f};
    bf16x8 At[4][2], B0[2][2], B1[2][2];
    const char* cA = g.a_tile(cur); const char* cB = g.b_tile(cur);
    {
        const char* cA1 = cA + g.a_koff(1);
        PG8_STAGE(PG8_SB(0, 0), cB, voffB); PG8_STAGE(PG8_SB(0, 1), cB + hstepB, voffB); PG8_STAGE(PG8_SA(0, 0), cA, voffA); PG8_STAGE(PG8_SA(0, 1), cA + hstepA, voffA);
        if (wr == 1) PG8_BAR;
        PG8_WAIT_V(2); PG8_BAR;
        PG8_STAGE(PG8_SB(1, 0), cB + kstep, voffB); PG8_STAGE(PG8_SA(1, 0), cA1, voffA); PG8_STAGE(PG8_SB(1, 1), cB + hstepB + kstep, voffB);
        PG8_WAIT_V(6); PG8_BAR;
    }
    for (;;) {
        const bool has_next = S.next(ui + 1, nxt);
        const char* nA = has_next ? g.a_tile(nxt) : cA; const char* nB = has_next ? g.b_tile(nxt) : cB;
        for (int t = 0; t < nt; t += 2) {
            const bool last = (t == nt - 2);
            const char* a1 = cA + g.a_koff(t + 1);
            const char* a2 = last ? nA : cA + g.a_koff(t + 2); const char* b2 = last ? nB : cB + (size_t)(t + 2) * kstep;
            const char* a3 = last ? nA + g.a_koff(1) : cA + g.a_koff(t + 3); const char* b3 = b2 + kstep;
            PG8_LDB(B0, 0, 0); PG8_LDB(B1, 0, 1); PG8_SCHED; PG8_LDA(At, 0, 0); PG8_STAGE(PG8_SA(1, 1), a1 + hstepA, voffA);
            PG8_WAIT_V(8); PG8_WAIT_L(0); PG8_BAR; PG8_MMA(0, 0, At, B0); PG8_MMA(0, 1, At, B1); PG8_BAR; PG8_SCHED;
            PG8_LDA(At, 0, 1); PG8_STAGE(PG8_SB(0, 0), b2, voffB); PG8_STAGE(PG8_SB(0, 1), b2 + hstepB, voffB); PG8_STAGE(PG8_SA(0, 0), a2, voffA);
            PG8_WAIT_V(8); PG8_WAIT_L(0); PG8_BAR; PG8_MMA(1, 0, At, B0); PG8_MMA(1, 1, At, B1); PG8_BAR; PG8_SCHED;
            PG8_LDB(B0, 1, 0); PG8_LDB(B1, 1, 1); PG8_SCHED; PG8_LDA(At, 1, 0); PG8_STAGE(PG8_SA(0, 1), a2 + hstepA, voffA);
            PG8_WAIT_V(8); PG8_WAIT_L(0); PG8_BAR; PG8_MMA(0, 0, At, B0); PG8_MMA(0, 1, At, B1); PG8_BAR; PG8_SCHED;
            PG8_LDA(At, 1, 1); PG8_STAGE(PG8_SB(1, 0), b3, voffB); PG8_STAGE(PG8_SB(1, 1), b3 + hstepB, voffB); PG8_STAGE(PG8_SA(1, 0), a3, voffA);
            PG8_WAIT_V(8); PG8_WAIT_L(0); PG8_BAR; PG8_MMA(1, 0, At, B0); PG8_MMA(1, 1, At, B1); PG8_BAR; PG8_SCHED;
        }
        if constexpr (ALIGN) { if (wr == 0) PG8_BAR; }
        if constexpr (F8) asm volatile("s_nop 15\n\ts_nop 15" ::: "memory");
        E(acc, cur, wr, wc, fr, fq);
        if (!has_next) break;
#pragma unroll
        for (int a = 0; a < 2; ++a)
#pragma unroll
            for (int b = 0; b < 2; ++b)
#pragma unroll
                for (int m = 0; m < 4; ++m)
#pragma unroll
                    for (int n = 0; n < 2; ++n) acc[a][b][m][n] = (f32x4){0.f, 0.f, 0.f, 0.f};
        cur = nxt; cA = nA; cB = nB; ++ui;
        if constexpr (ALIGN) { if (wr == 1) PG8_BAR; }
    }
    PG8_WAIT_V(0);
    if constexpr (!ALIGN) { if (wr == 0) PG8_BAR; }
    PG8_BAR;
#undef PG8_SA
#undef PG8_SB
#undef PG8_STAGE
#undef PG8_LDA
#undef PG8_LDB
#undef PG8_MMA
#undef PG8_WAIT_V
#undef PG8_WAIT_L
#undef PG8_BAR
#undef PG8_SCHED
}
}

namespace pg8 {
struct GCmp1 {
    const bf16_t* KV; const bf16_t* K1T; const bf16_t* V1T; unsigned lda2, ldb2; int K;
    __device__ __forceinline__ const char* a_tile(const Unit& u) const { const int which = u.pm >> 4, bg = u.pm & 15, b = bg >> 2, g = bg & 3;
        return (const char*)(KV + (size_t)b * S * 3072 + which * 512 + g * 128); }
    __device__ __forceinline__ const char* b_tile(const Unit& u) const { return (const char*)((u.pm >> 4) ? V1T : K1T); }
    __device__ __forceinline__ size_t a_koff(int t) const { return ((size_t)(t >> 1) * 3072 + (size_t)(t & 1) * 64) * 2; }
};
struct GCmp2 {
    const bf16_t* HK; const bf16_t* HV; const bf16_t* K2T; const bf16_t* V2T; unsigned lda2, ldb2; int K;
    __device__ __forceinline__ const char* a_tile(const Unit& u) const { return (const char*)(((u.pm >> 4) ? HV : HK) + (size_t)(u.pm & 15) * 256 * 256); }
    __device__ __forceinline__ const char* b_tile(const Unit& u) const { return (const char*)((u.pm >> 4) ? V2T : K2T); }
    __device__ __forceinline__ size_t a_koff(int t) const { return (size_t)t * 128; }
};

typedef f32x4 Acc[2][2][4][2];

struct EpiInProj {
    static constexpr bool PERM = false;
    bf16_t *Q, *KV, *CQ, *CKV; float *rssq, *rsskv; const float *ropeP;
    __device__ __forceinline__ void operator()(const Acc& acc, const Unit& u, int wr, int wc, int fr, int fq) const {
        { const int ln = (int)__builtin_amdgcn_mbcnt_hi(~0u, __builtin_amdgcn_mbcnt_lo(~0u, 0u)); fr = ln & 15; fq = ln >> 4; }
        const int pn = u.pn, rowb = u.pm * 256 + wr * 64 + fr;
        if (pn < 20) {
            bf16_t* dst; int ldo; bool rope;
            if (pn < 8) { dst = Q + pn * 256; ldo = 2048; rope = true; } else { dst = KV + (pn - 8) * 256; ldo = 3072; rope = ((((pn - 8) >> 1) & 1) == 0); }
            rope = rope && (wc == 0);
#pragma unroll
            for (int ai = 0; ai < 2; ++ai)
#pragma unroll
                for (int m = 0; m < 4; ++m) {
                    const int row = rowb + ai * 128 + m * 16;
                    f32x4 v[2][2];
#pragma unroll
                    for (int bj = 0; bj < 2; ++bj) { v[bj][0] = acc[ai][bj][m][0]; v[bj][1] = acc[ai][bj][m][1]; }
                    if (rope) { const f32x4 cs = *(const f32x4*)(ropeP + (size_t)row * 32 + 4 * fq), sn = *(const f32x4*)(ropeP + (size_t)row * 32 + 16 + 4 * fq);
#pragma unroll
                        for (int bj = 0; bj < 2; ++bj) { const f32x4 x1 = v[bj][0], x2 = v[bj][1]; v[bj][0] = x1 * cs - x2 * sn; v[bj][1] = x2 * cs + x1 * sn; } }
                    bf16_t* rp = dst + (size_t)row * ldo + wc * 32 + 4 * fq;
#pragma unroll
                    for (int bj = 0; bj < 2; ++bj)
#pragma unroll
                        for (int n = 0; n < 2; ++n) *(u32x2*)(rp + bj * 128 + n * 16) = pack4(v[bj][n]);
                }
        } else {
            const bool isq = pn < 26; const int tc = isq ? pn - 20 : pn - 26;
            bf16_t* dst = isq ? CQ + tc * 256 : CKV + tc * 256; const int ldo = isq ? QR : KVR;
#pragma unroll
            for (int ai = 0; ai < 2; ++ai)
#pragma unroll
                for (int m = 0; m < 4; ++m) {
                    const int row = rowb + ai * 128 + m * 16; float ss = 0.f;
                    bf16_t* rp = dst + (size_t)row * ldo + wc * 32 + 4 * fq; unsigned char* rp8 = (unsigned char*)(isq ? CQ : CKV) + (size_t)row * ldo + tc * 256 + wc * 32 + 4 * fq;
#pragma unroll
                    for (int bj = 0; bj < 2; ++bj)
#pragma unroll
                        for (int n = 0; n < 2; ++n) { const f32x4 x = acc[ai][bj][m][n]; ss += (x[0] * x[0] + x[1] * x[1]) + (x[2] * x[2] + x[3] * x[3]);
                            if constexpr (FP8_UP) *(unsigned*)(rp8 + bj * 128 + n * 16) = pack4_fp8(x[0], x[1], x[2], x[3]); else *(u32x2*)(rp + bj * 128 + n * 16) = pack4(x); }
                    ss += __shfl_xor(ss, 16); ss += __shfl_xor(ss, 32);
                    if (fq == 0) { if (isq) rssq[(size_t)row * 24 + tc * 4 + wc] = ss; else rsskv[(size_t)row * 8 + tc * 4 + wc] = ss; }
                }
        }
    }
};
struct EpiMisc {
    static constexpr bool PERM = false;
    bf16_t* KPE; float* gates; const float* ropeM;
    __device__ __forceinline__ void operator()(const Acc& acc, const Unit& u, int wr, int wc, int fr, int fq) const {
        { const int ln = (int)__builtin_amdgcn_mbcnt_hi(~0u, __builtin_amdgcn_mbcnt_lo(~0u, 0u)); fr = ln & 15; fq = ln >> 4; }
        const int rowb = u.pm * 256 + wr * 64 + fr;
        {
#pragma unroll
            for (int ai = 0; ai < 2; ++ai)
#pragma unroll
                for (int m = 0; m < 4; ++m) {
                    const int row = rowb + ai * 128 + m * 16;
                    if (wc < 2) {
                        const int i0 = 16 * wc + 4 * fq;
                        const f32x4 cs = *(const f32x4*)(ropeM + (size_t)row * 64 + i0), sn = *(const f32x4*)(ropeM + (size_t)row * 64 + 32 + i0);
                        const f32x4 x1 = acc[ai][0][m][0], x2 = acc[ai][0][m][1];
                        *(u32x2*)(KPE + (size_t)row * 64 + i0) = pack4(x1 * cs - x2 * sn);
                        *(u32x2*)(KPE + (size_t)row * 64 + 32 + i0) = pack4(x2 * cs + x1 * sn);
                    } else {
#pragma unroll
                        for (int n = 0; n < 2; ++n) { const int gi = 32 * (wc - 2) + 16 * n + 4 * fq;
                            if (gi < 48) { const f32x4 x = acc[ai][0][m][n]; f32x4 o;
#pragma unroll
                                for (int e = 0; e < 4; ++e) o[e] = 1.0f / (1.0f + __expf(-x[e]));
                                *(f32x4*)(gates + (size_t)row * 48 + gi) = o; } }
                    }
                }
        }
    }
};

struct EpiQUp {
    static constexpr bool PERM = false;
    bf16_t* Qm; const LAS float* rf; int row0; const float* ropeM;
    __device__ __forceinline__ void operator()(const Acc& acc, const Unit& u, int wr, int wc, int fr, int fq) const {
        { const int ln = (int)__builtin_amdgcn_mbcnt_hi(~0u, __builtin_amdgcn_mbcnt_lo(~0u, 0u)); fr = ln & 15; fq = ln >> 4; }
        const int pn = u.pn, rowb = u.pm * 256 + wr * 64 + fr;
#pragma unroll
        for (int ai = 0; ai < 2; ++ai)
#pragma unroll
            for (int m = 0; m < 4; ++m) {
                const int row = rowb + ai * 128 + m * 16;
                const float r = rf[row - row0];
                bf16_t* qrow = Qm + (size_t)row * 3072;
                if (pn < 8) {
#pragma unroll
                    for (int bj = 0; bj < 2; ++bj)
#pragma unroll
                        for (int n = 0; n < 2; ++n) *(u32x2*)(qrow + (2 * pn + bj) * 192 + wc * 32 + n * 16 + 4 * fq) = pack4(acc[ai][bj][m][n] * r);
                } else {
                    const int i0 = 16 * (wc & 1) + 4 * fq;
                    const f32x4 cs = *(const f32x4*)(ropeM + (size_t)row * 64 + i0), sn = *(const f32x4*)(ropeM + (size_t)row * 64 + 32 + i0);
#pragma unroll
                    for (int bj = 0; bj < 2; ++bj) { const int head = (pn - 8) * 4 + bj * 2 + (wc >> 1);
                        const f32x4 x1 = acc[ai][bj][m][0] * r, x2 = acc[ai][bj][m][1] * r;
                        *(u32x2*)(qrow + head * 192 + 128 + i0) = pack4(x1 * cs - x2 * sn);
                        *(u32x2*)(qrow + head * 192 + 160 + i0) = pack4(x2 * cs + x1 * sn); }
                }
                asm volatile("" ::: "memory");
            }
    }
};
struct EpiKVUp {
    static constexpr bool PERM = false;
    bf16_t *KN, *VM; const LAS float* rf; int row0;
    __device__ __forceinline__ void operator()(const Acc& acc, const Unit& u, int wr, int wc, int fr, int fq) const {
        { const int ln = (int)__builtin_amdgcn_mbcnt_hi(~0u, __builtin_amdgcn_mbcnt_lo(~0u, 0u)); fr = ln & 15; fq = ln >> 4; }
        const int pn = u.pn, rowb = u.pm * 256 + wr * 64 + fr;
        bf16_t* dst = pn < 8 ? KN + pn * 256 : VM + (pn - 8) * 256;
#pragma unroll
        for (int ai = 0; ai < 2; ++ai)
#pragma unroll
            for (int m = 0; m < 4; ++m) {
                const int row = rowb + ai * 128 + m * 16;
                const float r = rf[row - row0];
                bf16_t* rp = dst + (size_t)row * 2048 + wc * 32 + 4 * fq;
#pragma unroll
                for (int bj = 0; bj < 2; ++bj)
#pragma unroll
                    for (int n = 0; n < 2; ++n) *(u32x2*)(rp + bj * 128 + n * 16) = pack4(acc[ai][bj][m][n] * r);
                asm volatile("" ::: "memory");
            }
    }
};
struct EpiCmpHid {
    static constexpr bool PERM = false;
    bf16_t *HK, *HV; const float* bias;
    __device__ __forceinline__ void operator()(const Acc& acc, const Unit& u, int wr, int wc, int fr, int fq) const {
        { const int ln = (int)__builtin_amdgcn_mbcnt_hi(~0u, __builtin_amdgcn_mbcnt_lo(~0u, 0u)); fr = ln & 15; fq = ln >> 4; }
        const int which = u.pm >> 4; bf16_t* dst = (which ? HV : HK) + (size_t)(u.pm & 15) * 256 * 256; const float* bs = bias + which * 256;
#pragma unroll
        for (int bj = 0; bj < 2; ++bj)
#pragma unroll
            for (int n = 0; n < 2; ++n) { const int col = bj * 128 + wc * 32 + n * 16 + 4 * fq; const f32x4 bv = *(const f32x4*)(bs + col);
#pragma unroll
                for (int ai = 0; ai < 2; ++ai)
#pragma unroll
                    for (int m = 0; m < 4; ++m) { const int rl = ai * 128 + wr * 64 + m * 16 + fr; const f32x4 x = acc[ai][bj][m][n] + bv; f32x4 o;
#pragma unroll
                        for (int e = 0; e < 4; ++e) { const float v = x[e], uu = 0.7978845608028654f * (v + 0.044715f * v * v * v); const float tt = __builtin_amdgcn_exp2f(uu * (2.0f * LOG2E)); o[e] = v - v / (tt + 1.0f); }
                        if (rl == 255) o = (f32x4){0.f, 0.f, 0.f, 0.f};
                        *(u32x2*)(dst + (size_t)rl * 256 + col) = pack4(o); } }
    }
};
struct EpiCmpOut {
    static constexpr bool PERM = false;
    bf16_t *KC, *VC;
    __device__ __forceinline__ void operator()(const Acc& acc, const Unit& u, int wr, int wc, int fr, int fq) const {
        { const int ln = (int)__builtin_amdgcn_mbcnt_hi(~0u, __builtin_amdgcn_mbcnt_lo(~0u, 0u)); fr = ln & 15; fq = ln >> 4; }
        bf16_t* dst = ((u.pm >> 4) ? VC : KC) + (size_t)(u.pm & 15) * 256 * 128;
#pragma unroll
        for (int ai = 0; ai < 2; ++ai)
#pragma unroll
            for (int m = 0; m < 4; ++m) { const int rl = ai * 128 + wr * 64 + m * 16 + fr;
#pragma unroll
                for (int n = 0; n < 2; ++n) *(u32x2*)(dst + (size_t)rl * 128 + wc * 32 + n * 16 + 4 * fq) = pack4(acc[ai][0][m][n]); }
    }
};
__device__ __forceinline__ void unpack8(u32x4 w, f32x4& lo, f32x4& hi) {
    lo[0] = __uint_as_float(w.x << 16); lo[1] = __uint_as_float(w.x & 0xffff0000u); lo[2] = __uint_as_float(w.y << 16); lo[3] = __uint_as_float(w.y & 0xffff0000u);
    hi[0] = __uint_as_float(w.z << 16); hi[1] = __uint_as_float(w.z & 0xffff0000u); hi[2] = __uint_as_float(w.w << 16); hi[3] = __uint_as_float(w.w & 0xffff0000u);
}
__device__ __forceinline__ u32x4 pack8f(f32x4 lo, f32x4 hi) { u32x4 w; w.x = cvtpk(lo[0], lo[1]); w.y = cvtpk(lo[2], lo[3]); w.z = cvtpk(hi[0], hi[1]); w.w = cvtpk(hi[2], hi[3]); return w; }
struct EpiY1 {
    static constexpr bool PERM = true;
    const float* x; bf16_t* y1; const float* gate;
    __device__ __forceinline__ void operator()(const Acc& acc, const Unit& u, int wr, int wc, int fr, int fq) const {
        { const int ln = (int)__builtin_amdgcn_mbcnt_hi(~0u, __builtin_amdgcn_mbcnt_lo(~0u, 0u)); fr = ln & 15; fq = ln >> 4; }
        const int rowb = u.pm * 256 + wr * 64 + fr, col0 = u.pn * 256 + wc * 32 + 8 * fq; const int b = (u.pm * 256) / S;
        const size_t yb = (((size_t)u.pm * 16 + u.pn) * 256 + (wr * 64 + fr)) * 256 + wc * 32 + 8 * fq;
        f32x4 gv[2][2];
#pragma unroll
        for (int bj = 0; bj < 2; ++bj)
#pragma unroll
            for (int n = 0; n < 2; ++n) gv[bj][n] = *(const f32x4*)(gate + (size_t)b * NADA + col0 + bj * 128 + n * 4) + 1.0f;
        f32x4 bsA[2][2][2], bsB[2][2][2];
#define Y1_LOAD(dst, am) do { _Pragma("unroll") for (int mm = 0; mm < 2; ++mm) { const int m_ = ((am) & 1) * 2 + mm; const size_t off_ = (size_t)(rowb + ((am) >> 1) * 128 + m_ * 16) * D + col0; \
            _Pragma("unroll") for (int bj = 0; bj < 2; ++bj) _Pragma("unroll") for (int n = 0; n < 2; ++n) dst[mm][bj][n] = *(const f32x4*)(x + off_ + bj * 128 + n * 4); } } while (0)
#define Y1_STORE(src, am) do { _Pragma("unroll") for (int mm = 0; mm < 2; ++mm) { const int ai_ = (am) >> 1, m_ = ((am) & 1) * 2 + mm; const size_t off_ = yb + (size_t)(ai_ * 128 + m_ * 16) * 256;        \
            _Pragma("unroll") for (int bj = 0; bj < 2; ++bj) *(u32x4*)(y1 + off_ + bj * 128) = pack8f(src[mm][bj][0] * ALPHA + gv[bj][0] * acc[ai_][bj][m_][0], src[mm][bj][1] * ALPHA + gv[bj][1] * acc[ai_][bj][m_][1]); } } while (0)
        Y1_LOAD(bsA, 0);
        Y1_LOAD(bsB, 1); asm volatile("" ::: "memory");
        Y1_STORE(bsA, 0); asm volatile("" ::: "memory");
        Y1_LOAD(bsA, 2); asm volatile("" ::: "memory");
        Y1_STORE(bsB, 1); asm volatile("" ::: "memory");
        Y1_LOAD(bsB, 3); asm volatile("" ::: "memory");
        Y1_STORE(bsA, 2); asm volatile("" ::: "memory");
        Y1_STORE(bsB, 3);
#undef Y1_LOAD
#undef Y1_STORE
    }
};
struct EpiY2 {
    static constexpr bool PERM = true;
    const bf16_t* y1; bf16_t* y2; const float* gate; const float* stats; const float* lg; const float* lb;
    __device__ __forceinline__ void operator()(const Acc& acc, const Unit& u, int wr, int wc, int fr, int fq) const {
        { const int ln = (int)__builtin_amdgcn_mbcnt_hi(~0u, __builtin_amdgcn_mbcnt_lo(~0u, 0u)); fr = ln & 15; fq = ln >> 4; }
        const int rowb = u.pm * 256 + wr * 64 + fr, col0 = u.pn * 256 + wc * 32 + 8 * fq; const int b = (u.pm * 256) / S;
        const size_t yb = (((size_t)u.pm * 16 + u.pn) * 256 + (wr * 64 + fr)) * 256 + wc * 32 + 8 * fq;
#pragma unroll
        for (int bj = 0; bj < 2; ++bj) {
            f32x4 gm[2], G[2], Bc[2];
#pragma unroll
            for (int n = 0; n < 2; ++n) { const int c = col0 + bj * 128 + n * 4; gm[n] = *(const f32x4*)(gate + (size_t)b * NADA + c) + 1.0f; G[n] = *(const f32x4*)(lg + c) * ALPHA; Bc[n] = *(const f32x4*)(lb + c) * ALPHA; }
#pragma unroll
            for (int hf = 0; hf < 2; ++hf) {
                u32x4 yv[4]; f32x2 st[4];
#pragma unroll
                for (int m = 0; m < 4; ++m) { const int row = rowb + hf * 128 + m * 16; yv[m] = *(const u32x4*)(y1 + yb + (size_t)(hf * 128 + m * 16) * 256 + bj * 128); st[m] = *(const f32x2*)(stats + (size_t)row * 2); }
#pragma unroll
                for (int m = 0; m < 4; ++m) { const int row = rowb + hf * 128 + m * 16;
                    f32x4 lo, hi; unpack8(yv[m], lo, hi); const float r = st[m][1], mr = st[m][0] * r;
                    lo = (lo * r - mr) * G[0] + Bc[0] + gm[0] * acc[hf][bj][m][0]; hi = (hi * r - mr) * G[1] + Bc[1] + gm[1] * acc[hf][bj][m][1];
                    *(u32x4*)(y2 + yb + (size_t)(hf * 128 + m * 16) * 256 + bj * 128) = pack8f(lo, hi); }
                asm volatile("" ::: "memory");
            }
            asm volatile("" ::: "memory");
        }
    }
};
struct EpiRelu2 {
    static constexpr bool PERM = true;
    bf16_t* O;
    __device__ __forceinline__ void operator()(const Acc& acc, const Unit& u, int wr, int wc, int fr, int fq) const {
        { const int ln = (int)__builtin_amdgcn_mbcnt_hi(~0u, __builtin_amdgcn_mbcnt_lo(~0u, 0u)); fr = ln & 15; fq = ln >> 4; }
        const int rl = wr * 64 + fr, kt0 = u.pn * 4 + (wc >> 1), cl = (wc & 1) * 32 + 8 * fq;
#pragma unroll
        for (int ai = 0; ai < 2; ++ai)
#pragma unroll
            for (int m = 0; m < 4; ++m) { bf16_t* rp = O + (((size_t)u.pm * (DFF / 64) + kt0) * 256 + (rl + ai * 128 + m * 16)) * 64 + cl;
#pragma unroll
                for (int bj = 0; bj < 2; ++bj) { f32x4 v0 = acc[ai][bj][m][0], v1 = acc[ai][bj][m][1];
#pragma unroll
                    for (int e = 0; e < 4; ++e) { const float a = fmaxf(v0[e], 0.f), b = fmaxf(v1[e], 0.f); v0[e] = a * a; v1[e] = b * b; }
                    u32x4 w; w.x = cvtpk(v0[0], v0[1]); w.y = cvtpk(v0[2], v0[3]); w.z = cvtpk(v1[0], v1[1]); w.w = cvtpk(v1[2], v1[3]);
                    *(u32x4*)(rp + (size_t)bj * 2 * 256 * 64) = w; } }
    }
};
}

typedef GAS unsigned gu32;
#define RLX_AGENT __ATOMIC_RELAXED, __HIP_MEMORY_SCOPE_AGENT
#define XB_TMO      128
#define XB_XCNT(j)  (256  + 64 * (j))
#define XB_XSUB(j)  (1280 + 64 * (j))
#define XB_XGEN(j)  (2304 + 64 * (j))
#define XB_TOP      3328
#define XB_TOPGEN   3392
#define XCD_BAR_WORDS 3456
#define XB_SPIN_CAP (1u << 20)

__device__ __forceinline__ unsigned xb_ld(unsigned* p)              { return __hip_atomic_load(p, __ATOMIC_RELAXED, __HIP_MEMORY_SCOPE_AGENT); }
__device__ __forceinline__ unsigned xb_add(unsigned* p, unsigned v) { return __hip_atomic_fetch_add(p, v, __ATOMIC_RELAXED, __HIP_MEMORY_SCOPE_AGENT); }
__device__ __forceinline__ unsigned xb_xcc_id() { return (unsigned)__builtin_amdgcn_s_getreg((3 << 11) | 20) & 0xFu; }
#define XB_SPIN(cond, bar) do { unsigned _sp = 0; while (cond) { __builtin_amdgcn_s_sleep(1); \
    if ((++_sp & 255u) == 0u) { if (xb_ld(&(bar)[XB_TMO])) break; if (_sp > XB_SPIN_CAP) { atomicAdd(&(bar)[XB_TMO], 1u); break; } } } } while (0)

struct XcdBarrier { unsigned* bar; unsigned x; volatile LAS unsigned* st; };

__device__ __forceinline__ XcdBarrier xcd_barrier_post(unsigned* bar, volatile LAS unsigned* st) {
    XcdBarrier b; b.bar = bar; b.x = xb_xcc_id(); b.st = st;
    if (threadIdx.x == 0) (void)xb_add(&bar[XB_XCNT(b.x)], 1u);
    return b;
}
__device__ __forceinline__ void xcd_barrier_complete(unsigned* bar, unsigned x, unsigned& nloc, unsigned& nx) {
    const unsigned G = gridDim.x * gridDim.y * gridDim.z;
    unsigned sum, cnt, mine, sp = 0u;
    for (;;) {
        sum = 0u; cnt = 0u; mine = 0u;
#pragma unroll
        for (unsigned j = 0; j < 16; ++j) { const unsigned c = xb_ld(&bar[XB_XCNT(j)]); sum += c; cnt += (c > 0u) ? 1u : 0u; mine = (j == x) ? c : mine; }
        if (sum == G) break;
        __builtin_amdgcn_s_sleep(1);
        if ((++sp & 255u) == 0u) { if (xb_ld(&bar[XB_TMO])) break; if (sp > XB_SPIN_CAP) { atomicAdd(&bar[XB_TMO], 1u); break; } }
    }
    nloc = mine > 0u ? mine : 1u; nx = cnt > 0u ? cnt : 1u;
}
__device__ __forceinline__ void xcd_barrier(const XcdBarrier& b) {
    asm volatile("s_waitcnt vmcnt(0)" ::: "memory");
    __syncthreads();
    if (threadIdx.x == 0) {
        unsigned* bar = b.bar;
        __builtin_amdgcn_s_waitcnt(0);
        unsigned nloc = b.st[0], nx = b.st[1];
        if (nloc == 0u) { xcd_barrier_complete(bar, b.x, nloc, nx); b.st[0] = nloc; b.st[1] = nx; }
        const unsigned old = xb_add(&bar[XB_XSUB(b.x)], 1u);
        const unsigned gen = old / nloc;
        if (old + 1u == (gen + 1u) * nloc) {
            __builtin_amdgcn_fence(__ATOMIC_RELEASE, "agent");
            asm volatile("s_waitcnt vmcnt(0)" ::: "memory");
            const unsigned og = xb_add(&bar[XB_TOP], 1u);
            const unsigned tg = og / nx;
            if (og + 1u == (tg + 1u) * nx) xb_add(&bar[XB_TOPGEN], 1u);
            else XB_SPIN(xb_ld(&bar[XB_TOPGEN]) == tg, bar);
            __builtin_amdgcn_fence(__ATOMIC_ACQUIRE, "agent");
            xb_add(&bar[XB_XGEN(b.x)], 1u);
            asm volatile("s_waitcnt vmcnt(0)" ::: "memory");
        } else {
            XB_SPIN(xb_ld(&bar[XB_XGEN(b.x)]) == gen, bar);
            __builtin_amdgcn_fence(__ATOMIC_ACQUIRE, "agent");
            asm volatile("s_waitcnt vmcnt(0)" ::: "memory");
        }
    }
    __syncthreads();
}

struct Frame {
    LAS unsigned char* lds;
    volatile LAS unsigned* MISC;
    int tid, lane, wave, vcu, G;
    unsigned char* ws;
    const float *x, *c, *w_ada, *b_ada, *w_in, *pos_k, *pos_v, *k1, *k2, *v1, *v2, *qn, *kvn, *w_uq, *w_ukv, *w_out, *ln1g, *ln1b, *w_ff1, *w_ff2, *ln2g, *ln2b;
    const int* positions;
    float* out;
};

__device__ __forceinline__ int pairperm64(int p) { const int blk = p >> 4, i = p & 15; return blk == 0 ? i : (blk == 1 ? 32 + i : (blk == 2 ? 16 + i : 48 + i)); }
struct MapId { __device__ __forceinline__ int operator()(int j) const { return j; } };
struct MapPad { int n; __device__ __forceinline__ int operator()(int j) const { return j < n ? j : -1; } };
struct MapWin { __device__ __forceinline__ int operator()(int j) const {
    if (j < 5120) return j;
    if (j < 6656) return 5168 + (j - 5120);
    if (j < 7168) return 6704 + (j - 6656);
    const int jj = j - 7168;
    if (jj < 64) return 7216 + pairperm64(jj);
    if (jj < 112) return 5120 + (jj - 64);
    return -1; } };
struct MapUq { __device__ __forceinline__ int operator()(int j) const {
    if (j < 2048) return (j >> 7) * 192 + (j & 127);
    const int jj = j - 2048; return (jj >> 6) * 192 + 128 + pairperm64(jj & 63); } };
struct MapUkv { __device__ __forceinline__ int operator()(int j) const {
    if (j < 2048) return (j >> 7) * 256 + (j & 127);
    const int jj = j - 2048; return (jj >> 7) * 256 + 128 + (jj & 127); } };

__device__ __forceinline__ void blk8(int r, int KBs, int& kb, int& nb) { const int g = r >> 6, a = r & 63, gk = KBs >> 3; kb = 8 * (g % gk) + (a >> 3); nb = 8 * (g / gk) + (a & 7); }
__device__ __forceinline__ void blk16(int r, int KBs, int& kb, int& nb) { const int g = r >> 8, a = r & 255, gk = KBs >> 4; kb = 16 * (g % gk) + (a >> 4); nb = 16 * (g / gk) + (a & 15); }
template <bool F8 = false, class Map>
__device__ __forceinline__ void transpose_item(const float* __restrict__ W, int Nsrc, int K, void* WTv, const float* kscale, float mul, LAS float* scr, int kb, int nb, int lane, const Map map) {
    const int k0 = 64 * kb, j0 = 32 * nb, sc = map(j0 + (lane & 31)), kh = lane >> 5;
    float v[32];
#pragma unroll
    for (int i = 0; i < 32; ++i) v[i] = sc >= 0 ? W[(size_t)(k0 + 2 * i + kh) * Nsrc + sc] : 0.f;
    if (kscale) {
#pragma unroll
        for (int i = 0; i < 32; ++i) v[i] *= kscale[k0 + 2 * i + kh];
    }
#pragma unroll
    for (int i = 0; i < 32; ++i) scr[(2 * i + kh) * 33 + (lane & 31)] = v[i];
    asm volatile("s_waitcnt lgkmcnt(0)" ::: "memory");
    if constexpr (F8) {
        unsigned char* WT = (unsigned char*)WTv; const int c = lane & 3;
#pragma unroll
        for (int jj = 0; jj < 2; ++jj) { const int n = (lane >> 2) + 16 * jj; const LAS float* s = scr + (16 * c) * 33 + n;
            u32x4 o; o.x = pack4_fp8(s[0 * 33] * mul, s[1 * 33] * mul, s[2 * 33] * mul, s[3 * 33] * mul); o.y = pack4_fp8(s[4 * 33] * mul, s[5 * 33] * mul, s[6 * 33] * mul, s[7 * 33] * mul);
            o.z = pack4_fp8(s[8 * 33] * mul, s[9 * 33] * mul, s[10 * 33] * mul, s[11 * 33] * mul); o.w = pack4_fp8(s[12 * 33] * mul, s[13 * 33] * mul, s[14 * 33] * mul, s[15 * 33] * mul);
            *(u32x4*)(WT + (size_t)(j0 + n) * K + k0 + 16 * c) = o; }
    } else {
        bf16_t* WT = (bf16_t*)WTv; const int c = lane & 7;
#pragma unroll
        for (int jj = 0; jj < 4; ++jj) { const int n = (lane >> 3) + 8 * jj; const LAS float* s = scr + (8 * c) * 33 + n;
            u32x4 o; o.x = cvtpk(s[0 * 33], s[1 * 33]); o.y = cvtpk(s[2 * 33], s[3 * 33]); o.z = cvtpk(s[4 * 33], s[5 * 33]); o.w = cvtpk(s[6 * 33], s[7 * 33]);
            *(u32x4*)(WT + (size_t)(j0 + n) * K + k0 + 8 * c) = o; }
    }
    asm volatile("s_waitcnt lgkmcnt(0)" ::: "memory");
}

__device__ const double INVM[32] = {1.0, 0.6636012376960885, 0.44036660267178046, 0.2922278225730151, 0.19392274474868576, 0.12868737343265052, 0.08539710028576561, 0.05666962144529105,
    0.03760603093086393, 0.024955408670558694, 0.016560440080994446, 0.010989528534539826, 0.007292664737217109, 0.004839421345719893, 0.003211445994752591, 0.0021311195369119653,
    0.001414213562373095, 0.0009384738703573802, 0.000622772421914596, 0.0004132725499855165, 0.0002742481756762073, 0.00018199142881462546, 0.00012076973741146504, 8.01429472224798e-05,
    5.318295896944988e-05, 3.529227739646723e-05, 2.341999896140934e-05, 1.5541540297632344e-05, 1.031338537721246e-05, 6.8439753011549275e-06, 4.5416704806078695e-06, 3.013858152139171e-06};
__device__ __forceinline__ void sincos_d(double a, float& s, float& c) {
    const double k = __builtin_rint(a * 0.63661977236758134308);
    double r = __builtin_fma(-k, 1.57079632679489655800e+00, a); r = __builtin_fma(-k, 6.12323399573676603587e-17, r);
    const double r2 = r * r;
    double sp = -7.6471637318198164759e-13; sp = sp * r2 + 1.6059043836821614599e-10; sp = sp * r2 - 2.5052108385441718775e-08; sp = sp * r2 + 2.7557319223985890653e-06;
    sp = sp * r2 - 1.9841269841269841270e-04; sp = sp * r2 + 8.3333333333333333333e-03; sp = sp * r2 - 1.6666666666666666667e-01; const double sr = r + r * r2 * sp;
    double cp = 4.7794773323873852974e-14; cp = cp * r2 - 1.1470745597729724714e-11; cp = cp * r2 + 2.0876756987868098979e-09; cp = cp * r2 - 2.7557319223985890653e-07;
    cp = cp * r2 + 2.4801587301587301587e-05; cp = cp * r2 - 1.3888888888888888889e-03; cp = cp * r2 + 4.1666666666666666667e-02; cp = cp * r2 - 0.5; const double cr = 1.0 + r2 * cp;
    const int q = (int)k & 3;
    const double ss = (q == 0) ? sr : (q == 1) ? cr : (q == 2) ? -sr : -cr;
    const double cc = (q == 0) ? cr : (q == 1) ? -sr : (q == 2) ? -cr : sr;
    s = (float)ss; c = (float)cc;
}

__device__ __forceinline__ void p0_prologue(Frame& F) {
    unsigned char* ws = F.ws;
    const int gw = F.vcu * 8 + F.wave, NGW = F.G * 8, lane = F.lane;
    {
        float* modp = (float*)(ws + WS_MODP);
        for (int it = gw; it < 96 * ADA_KCH; it += NGW) {
            const int cc = it % 96, kc = it / 96, col = 256 * cc + 4 * lane;
            f32x4 a0 = {0.f, 0.f, 0.f, 0.f}, a1 = a0, a2 = a0, a3 = a0;
            for (int k8 = 0; k8 < 4; ++k8) {
                const int kbase = 256 * kc + 64 * k8;
                float s0, s1, s2, s3;
                { const float x0 = F.c[0 * D + kbase + lane], x1 = F.c[1 * D + kbase + lane], x2 = F.c[2 * D + kbase + lane], x3 = F.c[3 * D + kbase + lane];
                  s0 = x0 / (1.f + expf(-x0)); s1 = x1 / (1.f + expf(-x1)); s2 = x2 / (1.f + expf(-x2)); s3 = x3 / (1.f + expf(-x3)); }
                const float* wp = F.w_ada + (size_t)kbase * NADA + col;
#pragma unroll 16
                for (int kk = 0; kk < 64; ++kk) { const f32x4 w = *(const f32x4*)(wp + (size_t)kk * NADA);
                    a0 += w * rdlane(s0, kk); a1 += w * rdlane(s1, kk); a2 += w * rdlane(s2, kk); a3 += w * rdlane(s3, kk); }
            }
            *(f32x4*)(modp + ((size_t)(kc * 4 + 0)) * NADA + col) = a0; *(f32x4*)(modp + ((size_t)(kc * 4 + 1)) * NADA + col) = a1;
            *(f32x4*)(modp + ((size_t)(kc * 4 + 2)) * NADA + col) = a2; *(f32x4*)(modp + ((size_t)(kc * 4 + 3)) * NADA + col) = a3;
        }
    }
    {
        LAS float* scr = (LAS float*)(F.lds + F.wave * 16384);
        constexpr int I_IN = 64 * (DINP / 32), I_UQ = (QR / 64) * (3072 / 32), I_UKV = (KVR / 64) * (4096 / 32), I_OUT = 64 * 128, I_F1 = 64 * 512, I_F2 = 256 * 128, I_C1 = 64 * 8, I_C2 = 4 * 8;
        constexpr int NITEMS = I_IN + I_UQ + I_UKV + I_OUT + I_F1 + I_F2 + 2 * I_C1 + 2 * I_C2;
        for (int it = gw; it < NITEMS; it += NGW) {
            int r = it;
            if (r < I_F1) { int kb, nb; blk16(r, 64, kb, nb); transpose_item(F.w_ff1, DFF, D, (bf16_t*)(ws + WS_WFF1T), nullptr, 1.f, scr, kb, nb, lane, MapId{}); continue; } r -= I_F1;
            if (r < I_F2) { int kb, nb; blk16(r, 256, kb, nb); transpose_item(F.w_ff2, D, DFF, (bf16_t*)(ws + WS_WFF2T), nullptr, 1.f, scr, kb, nb, lane, MapId{}); continue; } r -= I_F2;
            if (r < I_IN) { int kb, nb; blk8(r, 64, kb, nb); transpose_item<FP8_IN>(F.w_in, 7280, D, (void*)(ws + WS_WINT), nullptr, FP8_IN ? 64.f : 1.f, scr, kb, nb, lane, MapWin{}); continue; } r -= I_IN;
            if (r < I_OUT) { int kb, nb; blk16(r, 64, kb, nb); transpose_item<FP8_OUT>(F.w_out, D, D, (void*)(ws + WS_WOUTT), nullptr, FP8_OUT ? 64.f : 1.f, scr, kb, nb, lane, MapId{}); continue; } r -= I_OUT;
            if (r < I_UQ) { transpose_item<FP8_UP>(F.w_uq, 3072, QR, (void*)(ws + WS_WUQT), F.qn, FP8_UP ? 32.f : 1.f, scr, r / 96, r % 96, lane, MapUq{}); continue; } r -= I_UQ;
            if (r < I_UKV) { transpose_item<FP8_UP>(F.w_ukv, 4096, KVR, (void*)(ws + WS_WUKVT), F.kvn, FP8_UP ? 16.f : 1.f, scr, r / 128, r % 128, lane, MapUkv{}); continue; } r -= I_UKV;
            if (r < I_C1) { transpose_item(F.k1, 256, 4096, (bf16_t*)(ws + WS_K1T), nullptr, 1.f, scr, r / 8, r % 8, lane, MapId{}); continue; } r -= I_C1;
            if (r < I_C1) { transpose_item(F.v1, 256, 4096, (bf16_t*)(ws + WS_V1T), nullptr, 1.f, scr, r / 8, r % 8, lane, MapId{}); continue; } r -= I_C1;
            if (r < I_C2) { transpose_item(F.k2, 128, 256, (bf16_t*)(ws + WS_SMALL + 65536), nullptr, 1.f, scr, r / 8, r % 8, lane, MapPad{128}); continue; } r -= I_C2;
            transpose_item(F.v2, 128, 256, (bf16_t*)(ws + WS_SMALL + 196608), nullptr, 1.f, scr, r / 8, r % 8, lane, MapPad{128});
        }
    }
    {
        float* rp = (float*)(ws + WS_ROPEP); float* rm = (float*)(ws + WS_ROPEM);
        const int gt = (F.vcu * 8 + F.wave) * 64 + lane, NT = F.G * 512;
        for (int e = gt; e < T * 32; e += NT) {
            const int t = e >> 5, i = e & 31;
            const double inv = INVM[i];
            float s, c; sincos_d((double)F.positions[t] * inv, s, c);
            rm[(size_t)t * 64 + i] = c; rm[(size_t)t * 64 + 32 + i] = s;
            if ((i & 1) == 0) { rp[(size_t)t * 32 + (i >> 1)] = c; rp[(size_t)t * 32 + 16 + (i >> 1)] = s; }
        }
    }
    {
        float* bias = (float*)(ws + WS_SMALL);
        for (int it = gw; it < 128; it += NGW) {
            const int which = it >> 6, cg = it & 63; const float* pos = which ? F.pos_v : F.pos_k; const float* w1 = which ? F.v1 : F.k1;
            f32x4 a = {0.f, 0.f, 0.f, 0.f};
            for (int k = lane; k < 4096; k += 64) a += *(const f32x4*)(w1 + (size_t)k * 256 + 4 * cg) * pos[k];
#pragma unroll
            for (int e = 0; e < 4; ++e) a[e] = wave_sum(a[e]);
            if (lane == 0) *(f32x4*)(bias + which * 256 + 4 * cg) = a;
        }
    }
}

__device__ __forceinline__ void p1_modulate(Frame& F) {
    unsigned char* ws = F.ws; const float* modp = (const float*)(ws + WS_MODP); float* modf = (float*)(ws + WS_MODF);
    if (blockIdx.x < 96) {
        for (int e = F.tid; e < 1024; e += 512) { const int idx = blockIdx.x * 1024 + e, col = idx % NADA; float s = F.b_ada[col];
#pragma unroll
            for (int kc = 0; kc < ADA_KCH; ++kc) s += modp[(size_t)kc * 4 * NADA + idx];
            modf[idx] = s; }
    }
    const int w = F.vcu, b = (w * 64) / S;
    LAS float* sh = (LAS float*)F.lds; LAS float* sc = sh + D;
    for (int e = F.tid; e < 2 * D; e += 512) { float s = F.b_ada[e];
#pragma unroll
        for (int kc = 0; kc < ADA_KCH; ++kc) s += modp[((size_t)kc * 4 + b) * NADA + e];
        sh[e] = (e < D) ? s : s + 1.0f; }
    __syncthreads();
    unsigned char* H8 = ws + WS_H;
    for (int rr = 0; rr < 8; ++rr) {
        const int row = w * 64 + F.wave * 8 + rr; const f32x4* xr = (const f32x4*)(F.x + (size_t)row * D); unsigned* hr = (unsigned*)(H8 + (size_t)row * D);
        f32x4 xv[16];
#pragma unroll
        for (int i = 0; i < 16; ++i) xv[i] = xr[F.lane + 64 * i];
        __builtin_amdgcn_sched_barrier(0);
#pragma unroll
        for (int i = 0; i < 16; ++i) { const int q = F.lane + 64 * i; const f32x4 sv = *(LAS f32x4*)(sc + 4 * q), hv = *(LAS f32x4*)(sh + 4 * q); const f32x4 o = xv[i] * sv + hv;
            if constexpr (FP8_IN) *(unsigned*)(H8 + ((((size_t)(row >> 8) * 32) + (q >> 5)) * 256 + (row & 255)) * 128 + 4 * (q & 31)) = pack4_fp8(o[0], o[1], o[2], o[3]); else        ((u32x2*)((bf16_t*)(ws + WS_H) + (size_t)row * D))[q] = pack4(o); }
    }
    __syncthreads();
}

__device__ __forceinline__ size_t ytile(int row, int col) { return ((((size_t)(row >> 8) * 16) + (col >> 8)) * 256 + (row & 255)) * 256 + (col & 255); }
template <bool LN1>
__device__ __forceinline__ void ln_phase(Frame& F, const bf16_t* Yin, const float* ga, const float* be, const float* modf, float* stats, bf16_t* ob16, float* of32) {
    const int lane = F.lane, w = F.wave, c0 = 512 * w + 8 * lane;
    LAS f32x2* red = (LAS f32x2*)F.lds;
    for (int rb = F.vcu * 64; rb < T; rb += F.G * 64) {
        const int b = rb / S;
        f32x4 ca[2], cb[2];
#pragma unroll
        for (int n = 0; n < 2; ++n) {
            if (LN1) { const f32x4 sc1 = *(const f32x4*)(modf + (size_t)b * NADA + 4 * D + c0 + 4 * n) + 1.0f, sh = *(const f32x4*)(modf + (size_t)b * NADA + 3 * D + c0 + 4 * n);
                ca[n] = *(const f32x4*)(ga + c0 + 4 * n) * sc1; cb[n] = *(const f32x4*)(be + c0 + 4 * n) * sc1 + sh; }
            else { ca[n] = *(const f32x4*)(ga + c0 + 4 * n); cb[n] = *(const f32x4*)(be + c0 + 4 * n); }
        }
        u32x4 nx[8];
#pragma unroll
        for (int k = 0; k < 8; ++k) nx[k] = *(const u32x4*)(Yin + ytile(rb + k, c0));
        for (int bt = 0; bt < 8; ++bt) {
            const int r0 = rb + 8 * bt; f32x4 v[8][2];
            LAS f32x2* rd = red + (bt & 1) * 64;
#pragma unroll
            for (int k = 0; k < 8; ++k) { pg8::unpack8(nx[k], v[k][0], v[k][1]);
                float s = ((v[k][0][0] + v[k][0][1]) + (v[k][0][2] + v[k][0][3])) + ((v[k][1][0] + v[k][1][1]) + (v[k][1][2] + v[k][1][3]));
                float q = ((v[k][0][0] * v[k][0][0] + v[k][0][1] * v[k][0][1]) + (v[k][0][2] * v[k][0][2] + v[k][0][3] * v[k][0][3])) + ((v[k][1][0] * v[k][1][0] + v[k][1][1] * v[k][1][1]) + (v[k][1][2] * v[k][1][2] + v[k][1][3] * v[k][1][3]));
                s = wave_sum(s); q = wave_sum(q);
                if (lane == 0) rd[k * 8 + w] = (f32x2){s, q}; }
            if (bt < 7) {
#pragma unroll
                for (int k = 0; k < 8; ++k) nx[k] = *(const u32x4*)(Yin + ytile(r0 + 8 + k, c0));
            }
            __syncthreads();
#pragma unroll
            for (int k = 0; k < 8; ++k) {
                float s = 0.f, q = 0.f;
#pragma unroll
                for (int ww = 0; ww < 8; ++ww) { const f32x2 p = rd[k * 8 + ww]; s += p[0]; q += p[1]; }
                const float mean = s * (1.0f / D), var = fmaxf(q * (1.0f / D) - mean * mean, 0.f), rstd = 1.0f / sqrtf(var + 1e-5f);
                const size_t ro = (size_t)(r0 + k) * D + c0;
                if (LN1) { if (w == 0 && lane == 0) *(f32x2*)(stats + (size_t)(r0 + k) * 2) = (f32x2){mean, rstd};
                    const int row = r0 + k; const size_t bo = ((((size_t)(row >> 8) * (D / 64)) + (c0 >> 6)) * 256 + (row & 255)) * 64 + (c0 & 63);
                    *(u32x4*)(ob16 + bo) = pg8::pack8f((v[k][0] - mean) * rstd * ca[0] + cb[0], (v[k][1] - mean) * rstd * ca[1] + cb[1]); }
                else { *(f32x4*)(of32 + ro) = (v[k][0] - mean) * rstd * ca[0] + cb[0]; *(f32x4*)(of32 + ro + 4) = (v[k][1] - mean) * rstd * ca[1] + cb[1]; }
            }
        }
        __syncthreads();
    }
}
__device__ __forceinline__ void ln1_phase(Frame& F, const float* modf) {
    ln_phase<true>(F, (const bf16_t*)(F.ws + WS_Y1), F.ln1g, F.ln1b, modf, (float*)(F.ws + WS_STATS), (bf16_t*)(F.ws + WS_H), nullptr);
}
__device__ __forceinline__ void ln2_phase(Frame& F) {
    ln_phase<false>(F, (const bf16_t*)(F.ws + WS_H), F.ln2g, F.ln2b, nullptr, nullptr, nullptr, F.out);
}

namespace att {
constexpr int KP = 400, VP = 320;
constexpr int KBUF = 64 * KP, VBUF = 64 * VP;
constexpr int OFF_K = 0, OFF_V = 2 * KBUF, OFF_IMPG = OFF_V + 2 * VBUF, OFF_IMPL = OFF_IMPG + 16384, OFF_SELM = OFF_IMPL + 16384, OFF_UNI = OFF_SELM + 512;
static_assert(OFF_UNI + 128 <= RING_BYTES, "attention LDS map");
enum { M_CMP1 = 0, M_CMP2 = 1, M_SEL = 2, M_WIN = 3, M_MLA = 4 };

struct Stage { u32x4 k0, k1, kp, v0, v1; };
template <bool HASP, bool HASV>
__device__ __forceinline__ void stage_load(Stage& st, const bf16_t* Kg, size_t ldk, const bf16_t* Pg, const bf16_t* Vg, size_t ldv, int tid) {
    const int r0 = tid >> 4, c0 = (tid & 15) * 8;
    st.k0 = *(const u32x4*)(Kg + (size_t)r0 * ldk + c0); st.k1 = *(const u32x4*)(Kg + (size_t)(r0 + 32) * ldk + c0);
    if (HASP) st.kp = *(const u32x4*)(Pg + (size_t)(tid >> 3) * 64 + (tid & 7) * 8);
    if (HASV) { st.v0 = *(const u32x4*)(Vg + (size_t)r0 * ldv + c0); st.v1 = *(const u32x4*)(Vg + (size_t)(r0 + 32) * ldv + c0); }
}
template <bool HASP, bool HASV>
__device__ __forceinline__ void stage_store(const Stage& st, LAS unsigned char* kbuf, LAS unsigned char* vbuf, int tid) {
    const int r0 = tid >> 4, c0 = (tid & 15) * 16;
    *(LAS u32x4*)(kbuf + r0 * KP + c0) = st.k0; *(LAS u32x4*)(kbuf + (r0 + 32) * KP + c0) = st.k1;
    if (HASP) *(LAS u32x4*)(kbuf + (tid >> 3) * KP + 256 + (tid & 7) * 16) = st.kp;
    if (HASV) { *(LAS u32x4*)(vbuf + r0 * VP + c0) = st.v0; *(LAS u32x4*)(vbuf + (r0 + 32) * VP + c0) = st.v1; }
}
__device__ __forceinline__ s16x4 vtr(const LAS unsigned char* p) { return __builtin_bit_cast(s16x4, __builtin_amdgcn_ds_read_tr16_b64_v4i16((LAS s16x4*)p)); }
__device__ __forceinline__ bf16x8 pack8(const f32x16& s, int o) {
    u32x4 w; w.x = cvtpk(s[o + 0], s[o + 1]); w.y = cvtpk(s[o + 2], s[o + 3]); w.z = cvtpk(s[o + 4], s[o + 5]); w.w = cvtpk(s[o + 6], s[o + 7]); return __builtin_bit_cast(bf16x8, w);
}

template <int MODE, int NQ>
__device__ __forceinline__ void run_seq(LAS unsigned char* lds, int tid, const bf16x8 (&qf)[NQ], f32x16 (&O)[4], float& m, float& l, const float C,
                                        const bf16_t* Kg, size_t ldk, const bf16_t* Pg, const bf16_t* Vg, size_t ldv,
                                        int jlo, int jhi, unsigned long long tmask, int hiB, int loB, unsigned long long mymask, int wmax, float inv_l, int tokl, int head) {
    constexpr bool HASP = (MODE == M_MLA), HASV = (MODE != M_CMP1);
    const int lane = tid & 63, hi = lane >> 5;
    const LAS unsigned char* kb_l = lds + OFF_K + (lane & 31) * KP + hi * 16;
    const LAS unsigned char* vb_l = lds + OFF_V + (4 * hi + ((lane & 15) >> 2)) * VP + (16 * ((lane >> 4) & 1) + 4 * (lane & 3)) * 2;
    int j; unsigned long long rem = 0ull;
    if (MODE == M_SEL) { rem = tmask; j = rem ? (int)__builtin_ctzll(rem) : -1; rem &= rem - 1ull; } else { j = jlo <= jhi ? jlo : -1; }
    Stage st;
    __syncthreads();
    if (j >= 0) stage_load<HASP, HASV>(st, Kg + (size_t)j * 64 * ldk, ldk, Pg + (size_t)j * 64 * 64, Vg + (size_t)j * 64 * ldv, ldv, tid);
    int it = 0;
    while (j >= 0) {
        const int bsel = it & 1;
        stage_store<HASP, HASV>(st, lds + OFF_K + bsel * KBUF, lds + OFF_V + bsel * VBUF, tid);
        __syncthreads();
        int jn;
        if (MODE == M_SEL) { jn = rem ? (int)__builtin_ctzll(rem) : -1; rem &= rem - 1ull; } else { jn = (j + 1 <= jhi) ? j + 1 : -1; }
        if (jn >= 0) stage_load<HASP, HASV>(st, Kg + (size_t)jn * 64 * ldk, ldk, Pg + (size_t)jn * 64 * 64, Vg + (size_t)jn * 64 * ldv, ldv, tid);
        const bool lvw = (MODE == M_SEL) ? (((mymask >> j) & 1ull) != 0ull) : true;
        if (!((MODE == M_MLA && 64 * j > wmax) || (MODE == M_SEL && !__any(lvw)))) {
            const LAS unsigned char* kb = kb_l + bsel * KBUF; const LAS unsigned char* vb = vb_l + bsel * VBUF;
            f32x16 s0, s1;
#pragma unroll
            for (int r = 0; r < 16; ++r) { s0[r] = 0.f; s1[r] = 0.f; }
            {
                constexpr int KW = (NQ == 8) ? 8 : ATT_KW12;
                bf16x8 kf[KW];
#pragma unroll
                for (int i = 0; i < KW; ++i) kf[i] = *(const LAS bf16x8*)(kb + (i & 1) * 32 * KP + (i >> 1) * 32);
                __builtin_amdgcn_sched_barrier(0);
#pragma unroll
                for (int i = 0; i < 2 * NQ; ++i) {
                    if (i & 1) s1 = __builtin_amdgcn_mfma_f32_32x32x16_bf16(kf[i % KW], qf[i >> 1], s1, 0, 0, 0);
                    else s0 = __builtin_amdgcn_mfma_f32_32x32x16_bf16(kf[i % KW], qf[i >> 1], s0, 0, 0, 0);
                    if (i + KW < 2 * NQ) { kf[i % KW] = *(const LAS bf16x8*)(kb + ((i + KW) & 1) * 32 * KP + ((i + KW) >> 1) * 32); __builtin_amdgcn_sched_barrier(0); }
                }
            }
            const int hl = hiB - 64 * j - 4 * hi, ll = loB - 64 * j - 4 * hi;
            const bool lv = lvw;
            bool need = true;
            if (MODE == M_WIN || MODE == M_MLA || MODE == M_SEL) need = __any(!((hl >= 63) && (ll < 0)));
            if (need) {
                const float NEG = -__builtin_inff();
#pragma unroll
                for (int r = 0; r < 16; ++r) { const int c = (r & 3) + 8 * (r >> 2);
                    if (!(lv && c <= hl && c > ll)) s0[r] = NEG;
                    if (!(lv && c + 32 <= hl && c + 32 > ll)) s1[r] = NEG; }
            }
            if (MODE == M_CMP2) {
#pragma unroll
                for (int r = 0; r < 16; ++r) { s0[r] = __builtin_amdgcn_exp2f(s0[r] * C - m) * inv_l; s1[r] = __builtin_amdgcn_exp2f(s1[r] * C - m) * inv_l; }
                LAS float* impG = (LAS float*)(lds + OFF_IMPG); LAS float* impL = (LAS float*)(lds + OFF_IMPL);
#pragma unroll
                for (int kb2 = 0; kb2 < 2; ++kb2)
#pragma unroll
                    for (int q4 = 0; q4 < 4; ++q4) {
                        const f32x16& sv = kb2 ? s1 : s0;
                        float gs = (sv[4 * q4] + sv[4 * q4 + 1]) + (sv[4 * q4 + 2] + sv[4 * q4 + 3]), ls = sv[4 * q4 + 3];
                        gs = quad_sum(gs); ls = quad_sum(ls);
                        const int jb = 16 * j + 8 * kb2 + 2 * q4 + hi;
                        if (head == 0) { impG[tokl * 64 + jb] = gs; if (jb + 1 < 64) impL[tokl * 64 + jb + 1] = ls; }
                    }
            } else {
                float mx = s0[0];
#pragma unroll
                for (int r = 1; r < 16; ++r) mx = fmaxf(mx, s0[r]);
#pragma unroll
                for (int r = 0; r < 16; ++r) mx = fmaxf(mx, s1[r]);
                mx = xhalf_max(mx);
                if (MODE == M_SEL) mx = lv ? mx : -__builtin_inff();
                const float mn = fmaxf(m, mx * C), alpha = __builtin_amdgcn_exp2f(m - mn);
                m = mn;
                float rs = 0.f; f32x2 rs2 = {0.f, 0.f};
#pragma unroll
                for (int r = 0; r < 16; r += 2) {
                    const f32x2 c2 = {C, C}, m2 = {mn, mn};
                    f32x2 a = {s0[r], s0[r + 1]}, b = {s1[r], s1[r + 1]};
                    a = __builtin_elementwise_fma(a, c2, -m2); b = __builtin_elementwise_fma(b, c2, -m2);
                    s0[r] = __builtin_amdgcn_exp2f(a[0]); s0[r + 1] = __builtin_amdgcn_exp2f(a[1]); s1[r] = __builtin_amdgcn_exp2f(b[0]); s1[r + 1] = __builtin_amdgcn_exp2f(b[1]);
                    const f32x2 ea = {s0[r], s0[r + 1]}, eb = {s1[r], s1[r + 1]}; rs2 += ea + eb; }
                rs = rs2[0] + rs2[1];
                rs = xhalf_sum(rs);
                if (MODE == M_SEL) rs = lv ? rs : 0.f;
                l = l * alpha + rs;
                if (MODE != M_CMP1) {
                    if (!__all(alpha == 1.0f)) {
#pragma unroll
                        for (int db = 0; db < 4; ++db)
#pragma unroll
                            for (int r = 0; r < 16; ++r) O[db][r] *= alpha;
                    }
                }
            }
            if (MODE != M_CMP1) {
                bf16x8 pf[4]; pf[0] = pack8(s0, 0); pf[1] = pack8(s0, 8); pf[2] = pack8(s1, 0); pf[3] = pack8(s1, 8);
                if (MODE == M_SEL) { const bf16x8 z = {0, 0, 0, 0, 0, 0, 0, 0};
#pragma unroll
                    for (int i = 0; i < 4; ++i) pf[i] = lv ? pf[i] : z; }
#pragma unroll
                for (int ks = 0; ks < 4; ++ks)
#pragma unroll
                    for (int db = 0; db < 4; ++db) {
                        const s16x4 lo = vtr(vb + (16 * ks) * VP + db * 64), hv = vtr(vb + (16 * ks + 8) * VP + db * 64);
                        const bf16x8 vf = {lo[0], lo[1], lo[2], lo[3], hv[0], hv[1], hv[2], hv[3]};
                        O[db] = __builtin_amdgcn_mfma_f32_32x32x16_bf16(vf, pf[ks], O[db], 0, 0, 0);
                    }
            }
        }
        j = jn; ++it;
    }
}

__device__ __forceinline__ void zero_o(f32x16 (&O)[4]) {
#pragma unroll
    for (int db = 0; db < 4; ++db)
#pragma unroll
        for (int r = 0; r < 16; ++r) O[db][r] = 0.f;
}

__device__ __forceinline__ void nsa_unit(Frame& F, int b, int g, int c) {
    unsigned char* ws = F.ws; LAS unsigned char* lds = F.lds;
    int tid = F.tid; asm volatile("" : "+v"(tid));
    const int lane = tid & 63, w = __builtin_amdgcn_readfirstlane(tid >> 6), ql = lane & 31, hi = lane >> 5, head = ql & 3, tokl = 8 * w + (ql >> 2);
    const int ts = 64 * c + tokl; const size_t trow = (size_t)b * S + ts; const int hg = g * 4 + head;
    const float C = 0.08838834764831845f * LOG2E;
    const bf16_t* KV = (const bf16_t*)(ws + WS_KVNSA) + (size_t)b * S * 3072 + g * 128;
    bf16_t* accb = (bf16_t*)(ws + WS_NSAACC) + trow * 2048 + hg * 128;
    bf16x8 qf[8];
    { const bf16_t* qrow = (const bf16_t*)(ws + WS_QNSA) + trow * 2048 + hg * 128 + 8 * hi;
#pragma unroll
      for (int d = 0; d < 8; ++d) qf[d] = *(const bf16x8*)(qrow + 16 * d); }
    const float* gp = (const float*)(ws + WS_GATES) + trow * 48 + hg * 3; const float gc = gp[0], gs = gp[1], gw = gp[2];
    f32x16 O[4]; float m, l;
    {
        const bf16_t* KC = (const bf16_t*)(ws + WS_KC) + (size_t)(b * 4 + g) * 256 * 128; const bf16_t* VC = (const bf16_t*)(ws + WS_VC) + (size_t)(b * 4 + g) * 256 * 128;
        const int nct = (4 * c + 2) / 64 + 1, limc = (ts - 31) >> 4;
        m = -1e30f; l = 0.f; zero_o(O);
        run_seq<M_CMP1, 8>(lds, tid, qf, O, m, l, C, KC, 128, KC, VC, 128, 0, nct - 1, 0ull, limc, -1, 0ull, 0, 0.f, tokl, head);
        const float inv_l = l > 0.f ? 1.0f / l : 0.f;
        run_seq<M_CMP2, 8>(lds, tid, qf, O, m, l, C, KC, 128, KC, VC, 128, 0, nct - 1, 0ull, limc, -1, 0ull, 0, inv_l, tokl, head);
#pragma unroll
        for (int db = 0; db < 4; ++db)
#pragma unroll
            for (int q4 = 0; q4 < 4; ++q4) { f32x4 o = {O[db][4 * q4], O[db][4 * q4 + 1], O[db][4 * q4 + 2], O[db][4 * q4 + 3]}; *(u32x2*)(accb + 32 * db + 8 * q4 + 4 * hi) = pack4(o * gc); }
    }
    __syncthreads();
    {
        LAS unsigned long long* selm = (LAS unsigned long long*)(lds + OFF_SELM); LAS unsigned long long* uni = (LAS unsigned long long*)(lds + OFF_UNI);
        const LAS float* impG = (const LAS float*)(lds + OFF_IMPG); const LAS float* impL = (const LAS float*)(lds + OFF_IMPL);
        unsigned long long wuni = 0ull;
        for (int tt = 0; tt < 8; ++tt) {
            const int tl = 8 * w + tt; unsigned long long mk;
            if (c >= 16) {
                const bool cand = (lane >= 1) && (lane <= c - 2);
                const float v = cand ? impG[tl * 64 + lane] + impL[tl * 64 + lane] : -__builtin_inff();
                int rank = 0;
                for (int i = 0; i < 64; ++i) { const float vi = rdlane(v, i); rank += ((vi > v) || (vi == v && i < lane)) ? 1 : 0; }
                mk = __ballot(cand && rank < 13) | 1ull | (1ull << c) | (1ull << (c - 1));
            } else mk = (2ull << c) - 1ull;
            if (lane == 0) selm[tl] = mk;
            wuni |= mk;
        }
        if (lane == 0) uni[w] = wuni;
    }
    __syncthreads();
    unsigned long long mymask, tmask = 0ull;
    { const LAS unsigned long long* selm = (const LAS unsigned long long*)(lds + OFF_SELM); const LAS unsigned long long* uni = (const LAS unsigned long long*)(lds + OFF_UNI);
      mymask = selm[tokl];
#pragma unroll
      for (int i = 0; i < 8; ++i) tmask |= uni[i];
      tmask &= (2ull << c) - 1ull;
      tmask = ((unsigned long long)(unsigned)__builtin_amdgcn_readfirstlane((int)(unsigned)(tmask >> 32)) << 32) | (unsigned long long)(unsigned)__builtin_amdgcn_readfirstlane((int)(unsigned)tmask); }
    m = -1e30f; l = 0.f; zero_o(O);
    run_seq<M_SEL, 8>(lds, tid, qf, O, m, l, C, KV + 2 * 512, 3072, KV, KV + 3 * 512, 3072, 0, c, tmask, ts, -1, mymask, 0, 0.f, tokl, head);
    { const float sc = l > 0.f ? gs / l : 0.f;
#pragma unroll
      for (int db = 0; db < 4; ++db)
#pragma unroll
          for (int q4 = 0; q4 < 4; ++q4) { bf16_t* p = accb + 32 * db + 8 * q4 + 4 * hi; f32x4 o = {O[db][4 * q4], O[db][4 * q4 + 1], O[db][4 * q4 + 2], O[db][4 * q4 + 3]}; const u32x2 w = *(const u32x2*)p;
              const f32x4 pr = {__uint_as_float(w.x << 16), __uint_as_float(w.x & 0xffff0000u), __uint_as_float(w.y << 16), __uint_as_float(w.y & 0xffff0000u)}; *(u32x2*)p = pack4(pr + o * sc); } }
    m = -1e30f; l = 0.f; zero_o(O);
    run_seq<M_WIN, 8>(lds, tid, qf, O, m, l, C, KV + 4 * 512, 3072, KV, KV + 5 * 512, 3072, c >= 8 ? c - 8 : 0, c, 0ull, ts, ts - 512, 0ull, 0, 0.f, tokl, head);
    { const float sc = l > 0.f ? gw / l : 0.f; unsigned char* orow = ws + WS_H + ((((trow >> 8) * 32) + hg) * 256 + (trow & 255)) * 128;
#pragma unroll
      for (int db = 0; db < 4; ++db)
#pragma unroll
          for (int q4 = 0; q4 < 4; ++q4) { const bf16_t* p = accb + 32 * db + 8 * q4 + 4 * hi; f32x4 o = {O[db][4 * q4], O[db][4 * q4 + 1], O[db][4 * q4 + 2], O[db][4 * q4 + 3]}; const u32x2 w = *(const u32x2*)p;
              const f32x4 pr = {__uint_as_float(w.x << 16), __uint_as_float(w.x & 0xffff0000u), __uint_as_float(w.y << 16), __uint_as_float(w.y & 0xffff0000u)};
              const f32x4 r = pr + o * sc;
              if constexpr (FP8_OUT) *(unsigned*)(orow + 32 * db + 8 * q4 + 4 * hi) = pack4_fp8(r[0] * 16.0f, r[1] * 16.0f, r[2] * 16.0f, r[3] * 16.0f);
              else *(u32x2*)((bf16_t*)(ws + WS_H) + trow * 4096 + hg * 128 + 32 * db + 8 * q4 + 4 * hi) = pack4(r); } }
}

__device__ __forceinline__ void mla_unit(Frame& F, int b, int hd, int qb) {
    unsigned char* ws = F.ws; LAS unsigned char* lds = F.lds;
    int tid = F.tid; asm volatile("" : "+v"(tid));
    const int lane = tid & 63, w = __builtin_amdgcn_readfirstlane(tid >> 6), ql = lane & 31, hi = lane >> 5;
    const int ts = 256 * qb + 32 * w + ql; const size_t trow = (size_t)b * S + ts;
    const float C = 0.07216878364870322f * LOG2E;
    bf16x8 qf[12];
    { const bf16_t* qrow = (const bf16_t*)(ws + WS_QMLA) + trow * 3072 + hd * 192 + 8 * hi;
#pragma unroll
      for (int d = 0; d < 12; ++d) qf[d] = *(const bf16x8*)(qrow + 16 * d); }
    const bf16_t* KN = (const bf16_t*)(ws + WS_KN) + (size_t)b * S * 2048 + hd * 128; const bf16_t* VM = (const bf16_t*)(ws + WS_VM) + (size_t)b * S * 2048 + hd * 128;
    const bf16_t* KPE = (const bf16_t*)(ws + WS_KPE) + (size_t)b * S * 64;
    f32x16 O[4]; float m = -1e30f, l = 0.f; zero_o(O);
    run_seq<M_MLA, 12>(lds, tid, qf, O, m, l, C, KN, 2048, KPE, VM, 2048, 0, 4 * qb + 3, 0ull, ts, -1, 0ull, 256 * qb + 32 * w + 31, 0.f, 0, 0);
    const float sc = l > 0.f ? (FP8_OUT ? 16.0f : 1.0f) / l : 0.f; unsigned char* orow = ws + WS_H + ((((trow >> 8) * 32) + 16 + hd) * 256 + (trow & 255)) * 128;
#pragma unroll
    for (int db = 0; db < 4; ++db)
#pragma unroll
        for (int q4 = 0; q4 < 4; ++q4) {
            if constexpr (FP8_OUT) *(unsigned*)(orow + 32 * db + 8 * q4 + 4 * hi) = pack4_fp8(O[db][4 * q4] * sc, O[db][4 * q4 + 1] * sc, O[db][4 * q4 + 2] * sc, O[db][4 * q4 + 3] * sc);
            else { f32x4 o = {O[db][4 * q4], O[db][4 * q4 + 1], O[db][4 * q4 + 2], O[db][4 * q4 + 3]}; *(u32x2*)((bf16_t*)(ws + WS_H) + trow * 4096 + 2048 + hd * 128 + 32 * db + 8 * q4 + 4 * hi) = pack4(o * sc); } }
}
}

struct Args { const void* in[23]; float* out; unsigned char* ws; int ph_lo, ph_hi; };
static_assert(sizeof(Args) == 23 * 8 + 8 + 8 + 8, "Args has no padding");

__global__ void __launch_bounds__(512, 2) fwd(Args args) {
    extern __shared__ __attribute__((aligned(16))) unsigned char lds_raw[];
    Frame F;
    F.lds = (LAS unsigned char*)lds_raw;
    F.MISC = (volatile LAS unsigned*)(F.lds + MISC_OFF);
    F.tid = threadIdx.x; F.lane = F.tid & 63; F.wave = __builtin_amdgcn_readfirstlane(F.tid >> 6);
    F.G = gridDim.x; { const int bx = blockIdx.x; F.vcu = (F.G % 8 == 0) ? (bx % 8) * (F.G / 8) + bx / 8 : bx; }
    F.ws = args.ws; F.out = args.out;
    F.x = (const float*)args.in[0]; F.c = (const float*)args.in[1]; F.positions = (const int*)args.in[2]; F.w_ada = (const float*)args.in[3]; F.b_ada = (const float*)args.in[4];
    F.w_in = (const float*)args.in[5]; F.pos_k = (const float*)args.in[6]; F.pos_v = (const float*)args.in[7]; F.k1 = (const float*)args.in[8]; F.k2 = (const float*)args.in[9];
    F.v1 = (const float*)args.in[10]; F.v2 = (const float*)args.in[11]; F.qn = (const float*)args.in[12]; F.kvn = (const float*)args.in[13]; F.w_uq = (const float*)args.in[14];
    F.w_ukv = (const float*)args.in[15]; F.w_out = (const float*)args.in[16]; F.ln1g = (const float*)args.in[17]; F.ln1b = (const float*)args.in[18]; F.w_ff1 = (const float*)args.in[19];
    F.w_ff2 = (const float*)args.in[20]; F.ln2g = (const float*)args.in[21]; F.ln2b = (const float*)args.in[22];
    unsigned char* ws = args.ws;
    for (int u = F.tid; u < (LDS_BYTES - LDSCTL_OFF) / 4; u += 512) ((LAS unsigned*)(F.lds + LDSCTL_OFF))[u] = 0u;
    __syncthreads();
    XcdBarrier bar; bar.bar = (unsigned*)(ws + WS_CTL) + CW_BAR; bar.x = 0; bar.st = nullptr;
    if (N_LAUNCHES == 1) bar = xcd_barrier_post((unsigned*)(ws + WS_CTL) + CW_BAR, F.MISC + 8);
    const int lo = args.ph_lo, hi = args.ph_hi;
#ifndef PH_MASK
#define PH_MASK 0x3ff
#endif
#ifndef REP_MASK
#define REP_MASK 0
#endif
#define NREP(k) (((REP_MASK >> (k)) & 1) ? 2 : 1)
#define IN(k) (((PH_MASK >> (k)) & 1) && lo <= (k) && (k) < hi)
#define SEAM(k) do { if (IN(k) && IN((k) + 1)) xcd_barrier(bar); } while (0)
    const float* modf = (const float*)(ws + WS_MODF);
    bf16_t* H = (bf16_t*)(ws + WS_H);

    if (IN(0)) { for (int rep = 0; rep < NREP(0); ++rep) { p0_prologue(F); __syncthreads(); } } SEAM(0);
    if (IN(1)) { for (int rep = 0; rep < NREP(1); ++rep) p1_modulate(F); } SEAM(1);
    if (IN(2)) {
        static_assert(FP8_IN && FP8_OUT, "the K-tile-blocked A images are written as e4m3"); pg8::GBlkA g{H, (const bf16_t*)(ws + WS_WINT), 128u, D * 1u, D / 2}; pg8::StaticOrder So; So.init(T, 7168, F.G, (int)blockIdx.x);
        pg8::EpiInProj E{(bf16_t*)(ws + WS_QNSA), (bf16_t*)(ws + WS_KVNSA), (bf16_t*)(ws + WS_CQ), (bf16_t*)(ws + WS_CKV), (float*)(ws + WS_RSSQ), (float*)(ws + WS_RSSKV), (const float*)(ws + WS_ROPEP)};
        pg8::gemm_phase<pg8::GBlkA, pg8::EpiInProj, pg8::StaticOrder, FP8_IN, 0x79797979, 0x7f7f7f7f, FF1_ALIGN>(F.lds, g, So, E);
    } SEAM(2);
    if (IN(3)) {
        const int m8 = F.vcu & 7, a8 = F.vcu >> 3;
        {
            pg8::GCmp1 g{(const bf16_t*)(ws + WS_KVNSA), (const bf16_t*)(ws + WS_K1T), (const bf16_t*)(ws + WS_V1T), 16u * 3072u * 2u, 4096u * 2u, 4096};
            pg8::RangeOrder So{a8, m8 == 0 ? 1 : 0, 1};
            pg8::EpiCmpHid E{(bf16_t*)(ws + WS_HIDK), (bf16_t*)(ws + WS_HIDV), (const float*)(ws + WS_SMALL)};
            pg8::gemm_phase(F.lds, g, So, E);
            asm volatile("s_waitcnt vmcnt(0)" ::: "memory"); __builtin_amdgcn_fence(__ATOMIC_RELEASE, "workgroup"); __syncthreads(); __builtin_amdgcn_fence(__ATOMIC_ACQUIRE, "agent"); asm volatile("s_waitcnt vmcnt(0)" ::: "memory");
            pg8::GCmp2 g2{(const bf16_t*)(ws + WS_HIDK), (const bf16_t*)(ws + WS_HIDV), (const bf16_t*)(ws + WS_SMALL + 65536), (const bf16_t*)(ws + WS_SMALL + 196608), 256u * 2u, 256u * 2u, 256};
            pg8::EpiCmpOut E2{(bf16_t*)(ws + WS_KC), (bf16_t*)(ws + WS_VC)};
            pg8::gemm_phase(F.lds, g2, So, E2);
        }
        {
            pg8::GBlkA g{H, (const bf16_t*)(ws + WS_WINT + (size_t)7168 * D), 128u, D * 1u, D / 2};
            pg8::RangeOrder So{2 * a8 + m8 - 1, (m8 == 1 || m8 == 2) ? 1 : 0, 1};
            pg8::EpiMisc E{(bf16_t*)(ws + WS_KPE), (float*)(ws + WS_GATES), (const float*)(ws + WS_ROPEM)};
            pg8::gemm_phase<pg8::GBlkA, pg8::EpiMisc, pg8::RangeOrder, FP8_IN, 0x79797979, 0x7f7f7f7f>(F.lds, g, So, E);
        }
        const int nq = (int)((0x0304040404020201ull >> (8 * m8)) & 0xff), pq = (int)((0x15110d0905030100ull >> (8 * m8)) & 0xff);
        const int nkv = (int)((0x0504040404040403ull >> (8 * m8)) & 0xff), pkv = (int)((0x1b17130f0b070300ull >> (8 * m8)) & 0xff);
        LAS float* rfq = (LAS float*)(F.lds + RING_BYTES + 4096); LAS float* rfkv = rfq + 512;
        {   const int row = 512 * a8 + F.tid;
            const f32x4* pq4 = (const f32x4*)((const float*)(ws + WS_RSSQ) + (size_t)row * 24); f32x4 sq = pq4[0];
#pragma unroll
            for (int i = 1; i < 6; ++i) sq += pq4[i];
            const f32x4* pk4 = (const f32x4*)((const float*)(ws + WS_RSSKV) + (size_t)row * 8); const f32x4 sk = pk4[0] + pk4[1];
            rfq[F.tid] = 1.0f / sqrtf(((sq[0] + sq[1]) + (sq[2] + sq[3])) * (1.0f / QR) + 1e-6f);
            rfkv[F.tid] = 1.0f / sqrtf(((sk[0] + sk[1]) + (sk[2] + sk[3])) * (1.0f / KVR) + 1e-6f);
            __syncthreads(); }
        {
            pg8::GLin g{(const bf16_t*)(ws + WS_CQ), (const bf16_t*)(ws + WS_WUQT), FP8_UP ? QR * 1u : QR * 2u, FP8_UP ? QR * 1u : QR * 2u, FP8_UP ? QR / 2 : QR}; pg8::RangeOrder So{24 * a8 + pq, nq, 12};
            pg8::EpiQUp E{(bf16_t*)(ws + WS_QMLA), rfq, 512 * a8, (const float*)(ws + WS_ROPEM)};
            pg8::gemm_phase<pg8::GLin, pg8::EpiQUp, pg8::RangeOrder, FP8_UP, 0x7a7a7a7a, 0x7f7f7f7f>(F.lds, g, So, E);
        }
        {
            pg8::GLin g{(const bf16_t*)(ws + WS_CKV), (const bf16_t*)(ws + WS_WUKVT), FP8_UP ? KVR * 1u : KVR * 2u, FP8_UP ? KVR * 1u : KVR * 2u, FP8_UP ? KVR / 2 : KVR}; pg8::RangeOrder So{32 * a8 + pkv, nkv, 16};
            pg8::EpiKVUp E{(bf16_t*)(ws + WS_KN), (bf16_t*)(ws + WS_VM), rfkv, 512 * a8};
            pg8::gemm_phase<pg8::GLin, pg8::EpiKVUp, pg8::RangeOrder, FP8_UP, 0x7b7b7b7b, 0x7f7f7f7f>(F.lds, g, So, E);
        }
    } SEAM(3);
    if (IN(4)) {
        if (F.wave >= 4) __builtin_amdgcn_s_setprio(1);
        for (int rep = 0; rep < NREP(11); ++rep)
        for (int item = F.vcu; item < 512; item += F.G) { const int bg = item >> 5, p = item & 31;

            for (int h2 = 0; h2 < 2; ++h2) att::nsa_unit(F, bg >> 2, bg & 3, h2 ? p : 63 - p); }
        for (int rep = 0; rep < NREP(12); ++rep)
        for (int item = F.vcu; item < 512; item += F.G) { const int bh = item >> 3, p = item & 7;

            for (int h2 = 0; h2 < 2; ++h2) att::mla_unit(F, bh >> 4, bh & 15, h2 ? p : 15 - p); }
        __builtin_amdgcn_s_setprio(0);
        __syncthreads();
    } SEAM(4);
    if (IN(5)) for (int rep = 0; rep < NREP(5); ++rep) {
        pg8::GBlkA g{H, (const bf16_t*)(ws + WS_WOUTT), 128u, D * 1u, D / 2}; pg8::StaticOrder So; So.init(T, D, F.G, (int)blockIdx.x);
        pg8::EpiY1 E{F.x, (bf16_t*)(ws + WS_Y1), modf + 2 * D};
        pg8::gemm_phase<pg8::GBlkA, pg8::EpiY1, pg8::StaticOrder, FP8_OUT, 0x79797979, 0x7b7b7b7b, FF1_ALIGN>(F.lds, g, So, E);
    } SEAM(5);
    if (IN(6)) { ln1_phase(F, modf); } SEAM(6);
    if (IN(7)) for (int rep = 0; rep < NREP(7); ++rep) {
        pg8::GBlkA g{H, (const bf16_t*)(ws + WS_WFF1T), 128u, D * 2u, D}; pg8::StaticOrder So; So.init(T, DFF, F.G, (int)blockIdx.x);
        pg8::EpiRelu2 E{(bf16_t*)(ws + WS_FFH)};
        pg8::gemm_phase<pg8::GBlkA, pg8::EpiRelu2, pg8::StaticOrder, false, 0x7f7f7f7f, 0x7f7f7f7f, FF1_ALIGN>(F.lds, g, So, E);
    } SEAM(7);
    if (IN(8)) {
        pg8::GBlkA g{(const bf16_t*)(ws + WS_FFH), (const bf16_t*)(ws + WS_WFF2T), 128u, DFF * 2u, DFF}; pg8::StaticOrder So; So.init(T, D, F.G, (int)blockIdx.x, FF2_WGM);
        pg8::EpiY2 E{(const bf16_t*)(ws + WS_Y1), (bf16_t*)(ws + WS_H), modf + 5 * D, (const float*)(ws + WS_STATS), F.ln1g, F.ln1b};
        pg8::gemm_phase<pg8::GBlkA, pg8::EpiY2, pg8::StaticOrder, false, 0x7f7f7f7f, 0x7f7f7f7f, FF1_ALIGN>(F.lds, g, So, E);
    } SEAM(8);
    if (IN(9)) { ln2_phase(F); }
#undef IN
#undef SEAM
}

extern "C" void kernel_launch(void* const* d_in, const int* in_sizes, int n_in, void* d_out, int out_size, void* d_ws, size_t ws_size, hipStream_t stream) {
    static int grid = 0;
    if (grid == 0) {
        if (n_in != 23 || in_sizes[0] != T * D || out_size != T * D || ws_size < WS_END) { fprintf(stderr, "kernel_launch: unexpected shapes (n_in %d, in0 %d, out %d, ws %zu)\n", n_in, n_in > 0 ? in_sizes[0] : -1, out_size, ws_size); grid = -1; return; }
        int dev = 0, cus = 0, per_cu = 0;
        if (hipGetDevice(&dev) != hipSuccess || hipDeviceGetAttribute(&cus, hipDeviceAttributeMultiprocessorCount, dev) != hipSuccess) { grid = -1; return; }
        if (hipFuncSetAttribute((const void*)fwd, hipFuncAttributeMaxDynamicSharedMemorySize, LDS_BYTES) != hipSuccess) { fprintf(stderr, "kernel_launch: hipFuncSetAttribute failed\n"); grid = -1; return; }
        if (hipOccupancyMaxActiveBlocksPerMultiprocessor(&per_cu, (const void*)fwd, 512, LDS_BYTES) != hipSuccess || per_cu < 1) fprintf(stderr, "kernel_launch: occupancy query reports %d\n", per_cu);
        (void)hipGetLastError();
        if (cus < 256) { fprintf(stderr, "kernel_launch: %d CUs; this kernel is laid out for 256 resident workgroups\n", cus); grid = -1; return; }
        grid = 256;
    }
    if (grid < 0) return;
    if (hipMemsetAsync((char*)d_ws + WS_CTL, 0, CTL_ZERO_BYTES, stream) != hipSuccess) return;
    Args a{};
    for (int i = 0; i < 23; ++i) a.in[i] = d_in[i];
    a.out = (float*)d_out; a.ws = (unsigned char*)d_ws;
    for (int li = 0; li < N_LAUNCHES; ++li) {
        a.ph_lo = (N_LAUNCHES == 1) ? 0 : li; a.ph_hi = (N_LAUNCHES == 1) ? NPHASE : li + 1;
        hipLaunchKernelGGL(fwd, dim3(grid), dim3(512), LDS_BYTES, stream, a);
        const hipError_t le = hipPeekAtLastError();
        if (le != hipSuccess) { fprintf(stderr, "kernel_launch: launch %d failed: %s\n", li, hipGetErrorName(le)); break; }
    }
}
```

```cpp
#include <hip/hip_runtime.h>
#include <cstdio>
#include <cstdint>

#define LAS __attribute__((address_space(3)))
#define GAS __attribute__((address_space(1)))
typedef unsigned short bf16_t;
typedef short bf16x8 __attribute__((ext_vector_type(8)));
typedef short s16x4 __attribute__((ext_vector_type(4)));
typedef float f32x2 __attribute__((ext_vector_type(2)));
typedef float f32x4 __attribute__((ext_vector_type(4)));
typedef float f32x16 __attribute__((ext_vector_type(16)));
typedef unsigned u32x2 __attribute__((ext_vector_type(2)));
typedef unsigned u32x4 __attribute__((ext_vector_type(4)));
typedef __bf16 bf16x2_t __attribute__((ext_vector_type(2)));

#ifndef MK_N_LAUNCHES
#define MK_N_LAUNCHES 1
#endif
constexpr int NPHASE = 10;
#ifndef FP8_IN_
#define FP8_IN_ 1
#endif
#ifndef FP8_OUT_
#define FP8_OUT_ 1
#endif
#ifndef FP8_UP_
#define FP8_UP_ 1
#endif
constexpr bool FP8_UP = FP8_UP_ != 0;
constexpr bool FP8_IN = FP8_IN_ != 0, FP8_OUT = FP8_OUT_ != 0;
constexpr int N_LAUNCHES = MK_N_LAUNCHES;

constexpr int NB = 4, S = 4096, D = 4096, T = NB * S;
constexpr int DINP = 7424;
constexpr int DFF = 16384;
constexpr int NADA = 6 * D;
constexpr int QR = 1536, KVR = 512;
constexpr float ALPHA = 1.189207115002721f;
constexpr float LOG2E = 1.4426950408889634f;
constexpr int ADA_KCH = 16;

constexpr size_t MiB = 1u << 20;
constexpr size_t WS_CTL = 0, CTL_ZERO_BYTES = 1 * MiB;
constexpr size_t WS_MODP = 1 * MiB;
constexpr size_t WS_MODF = 7 * MiB;
constexpr size_t WS_ROPEP = 8 * MiB;
constexpr size_t WS_ROPEM = 10 * MiB;
constexpr size_t WS_SMALL = 14 * MiB;
constexpr size_t WS_K1T = 15 * MiB, WS_V1T = 17 * MiB;
constexpr size_t WS_WINT = 19 * MiB;
constexpr size_t WS_WUQT = 77 * MiB;
constexpr size_t WS_WUKVT = 86 * MiB;
constexpr size_t WS_WOUTT = 90 * MiB;
constexpr size_t WS_WFF1T = 122 * MiB;
constexpr size_t WS_WFF2T = 250 * MiB;
constexpr size_t WS_H = 378 * MiB;
constexpr size_t WS_QNSA = 506 * MiB;
constexpr size_t WS_KVNSA = 570 * MiB;
constexpr size_t WS_CQ = 666 * MiB;
constexpr size_t WS_CKV = 714 * MiB;
constexpr size_t WS_KPE = 730 * MiB;
constexpr size_t WS_GATES = 732 * MiB;
constexpr size_t WS_RSSQ = 735 * MiB;
constexpr size_t WS_RSSKV = 737 * MiB;
constexpr size_t WS_HIDK = 738 * MiB, WS_HIDV = 740 * MiB;
constexpr size_t WS_KC = 742 * MiB, WS_VC = 743 * MiB;
constexpr size_t WS_QMLA = 744 * MiB;
constexpr size_t WS_KN = 840 * MiB;
constexpr size_t WS_VM = 904 * MiB;
constexpr size_t WS_NSAACC = 968 * MiB;
constexpr size_t WS_FFH = 506 * MiB;
constexpr size_t WS_Y1 = 1100 * MiB;
constexpr size_t WS_STATS = 1230 * MiB;
constexpr size_t WS_END = 1232 * MiB;
#ifndef FF1_ALIGN
#define FF1_ALIGN false
#endif
#ifndef ATT_KW12
#define ATT_KW12 12
#endif
#ifndef FF2_WGM
#define FF2_WGM 4
#endif
constexpr int CW_BAR = 4096;

constexpr int RING_BYTES = 131072;
constexpr int LDSCTL_OFF = RING_BYTES, MISC_OFF = LDSCTL_OFF + 320;
constexpr int LDS_BYTES = 147456;

__device__ __forceinline__ unsigned cvtpk(float lo, float hi) { f32x2 v = {lo, hi}; bf16x2_t b = __builtin_convertvector(v, bf16x2_t); return __builtin_bit_cast(unsigned, b); }
__device__ __forceinline__ u32x2 pack4(f32x4 v) { u32x2 w; w.x = cvtpk(v[0], v[1]); w.y = cvtpk(v[2], v[3]); return w; }
__device__ __forceinline__ unsigned pack4_fp8(float a, float b, float c, float d) { unsigned w = 0u; w = (unsigned)__builtin_amdgcn_cvt_pk_fp8_f32(a, b, (int)w, false); w = (unsigned)__builtin_amdgcn_cvt_pk_fp8_f32(c, d, (int)w, true); return w; }
__device__ __forceinline__ float wave_sum(float v) {
#pragma unroll
    for (int o = 1; o < 64; o <<= 1) v += __shfl_xor(v, o);
    return v;
}
__device__ __forceinline__ float xhalf_max(float x) { const auto r = __builtin_amdgcn_permlane32_swap(__float_as_uint(x), __float_as_uint(x), false, false); return fmaxf(__uint_as_float(r[0]), __uint_as_float(r[1])); }
__device__ __forceinline__ float xhalf_sum(float x) { const auto r = __builtin_amdgcn_permlane32_swap(__float_as_uint(x), __float_as_uint(x), false, false); return __uint_as_float(r[0]) + __uint_as_float(r[1]); }
__device__ __forceinline__ float quad_sum(float x) {
    x += __int_as_float(__builtin_amdgcn_mov_dpp(__float_as_int(x), 0xB1, 0xf, 0xf, true));
    x += __int_as_float(__builtin_amdgcn_mov_dpp(__float_as_int(x), 0x4E, 0xf, 0xf, true));
    return x; }
__device__ __forceinline__ float rdlane(float v, int l) { return __int_as_float(__builtin_amdgcn_readlane(__float_as_int(v), l)); }

namespace pg8 {
constexpr int BM = 256, BK = 64, HALF = 128, HTB = HALF * BK * 2, STAGE_BYTES = 8 * HTB, NXCD = 8, WGM = 8;
__host__ __device__ __forceinline__ int lds_byte(int r, int c) { const int st = (r >> 4) * 2 + (c >> 5), rr = r & 15, cc = c & 31, ob = rr * 64 + cc * 2; return st * 1024 + (ob ^ (((ob >> 9) & 1) << 5)); }
__host__ __device__ __forceinline__ void stage_rc(int b, int& R, int& C) { const int st = b / 1024, sb = b % 1024, swz = sb ^ (((sb >> 9) & 1) << 5); R = (st >> 1) * 16 + swz / 64; C = (st & 1) * 32 + (swz % 64) / 2; }
__host__ __device__ __forceinline__ int perm32(int rho) { const int n = rho >> 4, i = rho & 15; return 8 * (i >> 2) + 4 * n + (i & 3); }

struct Unit { int pm, pn; };

struct GLin {
    const bf16_t* A; const bf16_t* Bt; unsigned lda2, ldb2; int K;
    __device__ __forceinline__ const char* a_tile(const Unit& u) const { return (const char*)A + (size_t)u.pm * 256 * lda2; }
    __device__ __forceinline__ const char* b_tile(const Unit& u) const { return (const char*)Bt + (size_t)u.pn * 256 * ldb2; }
    __device__ __forceinline__ size_t a_koff(int t) const { return (size_t)t * 128; }
};

struct GBlkA {
    const bf16_t* A; const bf16_t* Bt; unsigned lda2, ldb2; int K;
    __device__ __forceinline__ const char* a_tile(const Unit& u) const { return (const char*)A + (size_t)u.pm * (size_t)(K / 64) * 32768; }
    __device__ __forceinline__ const char* b_tile(const Unit& u) const { return (const char*)Bt + (size_t)u.pn * 256 * ldb2; }
    __device__ __forceinline__ size_t a_koff(int t) const { return (size_t)t * 32768; }
};

struct StaticOrder {
    int nM, nN, nwg, G, c, wgm;
    __device__ void init(int M, int N, int G_, int c_, int wgm_ = WGM) { nM = M / BM; nN = N / BM; nwg = nM * nN; G = G_; c = c_; wgm = wgm_; }
    __device__ bool next(int i, Unit& u) const {
        const long L = (long)i * G + c; if (L >= nwg) return false;
        int wgid = (int)L; { const int q = nwg / NXCD, r = nwg % NXCD, xcd = wgid % NXCD, off = wgid / NXCD; wgid = (xcd < r ? xcd * (q + 1) : r * (q + 1) + (xcd - r) * q) + off; }
        const int nig = wgm * nN, gid = wgid / nig, fm = gid * wgm, gsz = (nM - fm) < wgm ? (nM - fm) : wgm;
        u.pm = fm + ((wgid % nig) % gsz); u.pn = (wgid % nig) / gsz; return true;
    }
};
struct ListOrder {
    int n, G, c;
    __device__ bool next(int i, Unit& u) const { const int L = i * G + c; if (L >= n) return false; u.pm = L; u.pn = 0; return true; }
};

struct RangeOrder {
    int start, cnt, nN;
    __device__ bool next(int i, Unit& u) const { if (i >= cnt) return false; const int L = start + i; u.pm = L / nN; u.pn = L - u.pm * nN; return true; }
};

typedef int i32x4 __attribute__((ext_vector_type(4)));
typedef int i32x8 __attribute__((ext_vector_type(8)));
__device__ __forceinline__ i32x8 cat8(bf16x8 lo, bf16x8 hi) { const i32x4 a = __builtin_bit_cast(i32x4, lo), b = __builtin_bit_cast(i32x4, hi); return __builtin_shufflevector(a, b, 0, 1, 2, 3, 4, 5, 6, 7); }
template <class GD, class Epi, class Sched, bool F8 = false, int SCALE_W = 0x7f7f7f7f, int SCALE_A = 0x7f7f7f7f, bool ALIGN = true>
__device__ __forceinline__ void gemm_phase(LAS unsigned char* lds, const GD g, const Sched& S, const Epi& E) {
    const int tid = threadIdx.x, wid = __builtin_amdgcn_readfirstlane(tid >> 6), lane = tid & 63, wr = wid >> 2, wc = wid & 3, fr = lane & 15, fq = lane >> 4;
    const int K = g.K, nt = K / BK;
    unsigned voffA, voffB;
    { int R, C; stage_rc(tid * 16, R, C); const int Rb = Epi::PERM ? ((R & ~31) + perm32(R & 31)) : R;
      voffA = (unsigned)R * g.lda2 + (unsigned)C * 2u; voffB = (unsigned)Rb * g.ldb2 + (unsigned)C * 2u; }
    const size_t pvoffA = (size_t)64 * g.lda2, pvoffB = (size_t)64 * g.ldb2;
    const size_t kstep = (size_t)(BK * 2);
    const size_t hstepA = (size_t)HALF * g.lda2, hstepB = (size_t)HALF * g.ldb2;
    const unsigned ldsw = (unsigned)wid * 1024u;
    const int aoff = lds_byte(wr * 64 + fr, fq * 8), boff = lds_byte(wc * 32 + fr, fq * 8);
#define PG8_SA(b, h) (((b) * 2 + (h)) * HTB)
#define PG8_SB(b, h) ((4 + (b) * 2 + (h)) * HTB)
#define PG8_STAGE(bufoff, gbase, voff) do { _Pragma("unroll") for (int _i = 0; _i < 2; ++_i) \
        __builtin_amdgcn_global_load_lds((const unsigned*)((const char*)(gbase) + (size_t)_i * p##voff + (voff)), (LAS unsigned*)(lds + (bufoff) + ldsw + _i * 8192), 16, 0, 0); } while (0)
#define PG8_LDA(dst, b, h) do { _Pragma("unroll") for (int m = 0; m < 4; ++m) _Pragma("unroll") for (int k = 0; k < 2; ++k) dst[m][k] = *(const LAS bf16x8*)(lds + PG8_SA(b, h) + aoff + m * 2048 + k * 1024); } while (0)
#define PG8_LDB(dst, b, h) do { _Pragma("unroll") for (int n = 0; n < 2; ++n) _Pragma("unroll") for (int k = 0; k < 2; ++k) dst[n][k] = *(const LAS bf16x8*)(lds + PG8_SB(b, h) + boff + n * 2048 + k * 1024); } while (0)
#define PG8_MMA(ai, bj, At, Bt) do { __builtin_amdgcn_s_setprio(1); _Pragma("unroll") for (int m = 0; m < 4; ++m) _Pragma("unroll") for (int n = 0; n < 2; ++n) { \
        if constexpr (F8) { const i32x8 _b8 = cat8(Bt[n][0], Bt[n][1]), _a8 = cat8(At[m][0], At[m][1]); \
            asm volatile("v_mfma_scale_f32_16x16x128_f8f6f4 %0, %1, %2, %0, %3, %4 op_sel_hi:[0,0,0]" : "+v"(acc[ai][bj][m][n]) : "v"(_b8), "v"(_a8), "v"(scw), "v"(sca)); } \
        else { _Pragma("unroll") for (int k = 0; k < 2; ++k) acc[ai][bj][m][n] = __builtin_amdgcn_mfma_f32_16x16x32_bf16(Bt[n][k], At[m][k], acc[ai][bj][m][n], 0, 0, 0); } } \
        __builtin_amdgcn_s_setprio(0); } while (0)
#define PG8_WAIT_V(n) asm volatile("s_waitcnt vmcnt(" #n ")" ::: "memory")
#define PG8_WAIT_L(n) asm volatile("s_waitcnt lgkmcnt(" #n ")" ::: "memory")
#define PG8_BAR __builtin_amdgcn_s_barrier()
#define PG8_SCHED __builtin_amdgcn_sched_barrier(0)
    Unit cur, nxt; int ui = 0;
    if (!S.next(0, cur)) return;
    const int scw = SCALE_W, sca = SCALE_A;
    f32x4 acc[2][2][4][2];
#pragma unroll
    for (int a = 0; a < 2; ++a)
#pragma unroll
        for (int b = 0; b < 2; ++b)
#pragma unroll
            for (int m = 0; m < 4; ++m)
#pragma unroll
                for (int n = 0; n < 2; ++n) acc[a][b][m][n] = (f32x4){0.f, 0.f, 0.f, 0.f};
    bf16x8 At[4][2], B0[2][2], B1[2][2];
    const char* cA = g.a_tile(cur); const char* cB = g.b_tile(cur);
    {
        const char* cA1 = cA + g.a_koff(1);
        PG8_STAGE(PG8_SB(0, 0), cB, voffB); PG8_STAGE(PG8_SB(0, 1), cB + hstepB, voffB); PG8_STAGE(PG8_SA(0, 0), cA, voffA); PG8_STAGE(PG8_SA(0, 1), cA + hstepA, voffA);
        if (wr == 1) PG8_BAR;
        PG8_WAIT_V(2); PG8_BAR;
        PG8_STAGE(PG8_SB(1, 0), cB + kstep, voffB); PG8_STAGE(PG8_SA(1, 0), cA1, voffA); PG8_STAGE(PG8_SB(1, 1), cB + hstepB + kstep, voffB);
        PG8_WAIT_V(6); PG8_BAR;
    }
    for (;;) {
        const bool has_next = S.next(ui + 1, nxt);
        const char* nA = has_next ? g.a_tile(nxt) : cA; const char* nB = has_next ? g.b_tile(nxt) : cB;
        for (int t = 0; t < nt; t += 2) {
            const bool last = (t == nt - 2);
            const char* a1 = cA + g.a_koff(t + 1);
            const char* a2 = last ? nA : cA + g.a_koff(t + 2); const char* b2 = last ? nB : cB + (size_t)(t + 2) * kstep;
            const char* a3 = last ? nA + g.a_koff(1) : cA + g.a_koff(t + 3); const char* b3 = b2 + kstep;
            PG8_LDB(B0, 0, 0); PG8_LDB(B1, 0, 1); PG8_SCHED; PG8_LDA(At, 0, 0); PG8_STAGE(PG8_SA(1, 1), a1 + hstepA, voffA);
            PG8_WAIT_V(8); PG8_WAIT_L(0); PG8_BAR; PG8_MMA(0, 0, At, B0); PG8_MMA(0, 1, At, B1); PG8_BAR; PG8_SCHED;
            PG8_LDA(At, 0, 1); PG8_STAGE(PG8_SB(0, 0), b2, voffB); PG8_STAGE(PG8_SB(0, 1), b2 + hstepB, voffB); PG8_STAGE(PG8_SA(0, 0), a2, voffA);
            PG8_WAIT_V(8); PG8_WAIT_L(0); PG8_BAR; PG8_MMA(1, 0, At, B0); PG8_MMA(1, 1, At, B1); PG8_BAR; PG8_SCHED;
            PG8_LDB(B0, 1, 0); PG8_LDB(B1, 1, 1); PG8_SCHED; PG8_LDA(At, 1, 0); PG8_STAGE(PG8_SA(0, 1), a2 + hstepA, voffA);
            PG8_WAIT_V(8); PG8_WAIT_L(0); PG8_BAR; PG8_MMA(0, 0, At, B0); PG8_MMA(0, 1, At, B1); PG8_BAR; PG8_SCHED;
            PG8_LDA(At, 1, 1); PG8_STAGE(PG8_SB(1, 0), b3, voffB); PG8_STAGE(PG8_SB(1, 1), b3 + hstepB, voffB); PG8_STAGE(PG8_SA(1, 0), a3, voffA);
            PG8_WAIT_V(8); PG8_WAIT_L(0); PG8_BAR; PG8_MMA(1, 0, At, B0); PG8_MMA(1, 1, At, B1); PG8_BAR; PG8_SCHED;
        }
        if constexpr (ALIGN) { if (wr == 0) PG8_BAR; }
        if constexpr (F8) asm volatile("s_nop 15\n\ts_nop 15" ::: "memory");
        E(acc, cur, wr, wc, fr, fq);
        if (!has_next) break;
#pragma unroll
        for (int a = 0; a < 2; ++a)
#pragma unroll
            for (int b = 0; b < 2; ++b)
#pragma unroll
                for (int m = 0; m < 4; ++m)
#pragma unroll
                    for (int n = 0; n < 2; ++n) acc[a][b][m][n] = (f32x4){0.f, 0.f, 0.f, 0.f};
        cur = nxt; cA = nA; cB = nB; ++ui;
        if constexpr (ALIGN) { if (wr == 1) PG8_BAR; }
    }
    PG8_WAIT_V(0);
    if constexpr (!ALIGN) { if (wr == 0) PG8_BAR; }
    PG8_BAR;
#undef PG8_SA
#undef PG8_SB
#undef PG8_STAGE
#undef PG8_LDA
#undef PG8_LDB
#undef PG8_MMA
#undef PG8_WAIT_V
#undef PG8_WAIT_L
#undef PG8_BAR
#undef PG8_SCHED
}
}

namespace pg8 {
struct GCmp1 {
    const bf16_t* KV; const bf16_t* K1T; const bf16_t* V1T; unsigned lda2, ldb2; int K;
    __device__ __forceinline__ const char* a_tile(const Unit& u) const { const int which = u.pm >> 4, bg = u.pm & 15, b = bg >> 2, g = bg & 3;
        return (const char*)(KV + (size_t)b * S * 3072 + which * 512 + g * 128); }
    __device__ __forceinline__ const char* b_tile(const Unit& u) const { return (const char*)((u.pm >> 4) ? V1T : K1T); }
    __device__ __forceinline__ size_t a_koff(int t) const { return ((size_t)(t >> 1) * 3072 + (size_t)(t & 1) * 64) * 2; }
};
struct GCmp2 {
    const bf16_t* HK; const bf16_t* HV; const bf16_t* K2T; const bf16_t* V2T; unsigned lda2, ldb2; int K;
    __device__ __forceinline__ const char* a_tile(const Unit& u) const { return (const char*)(((u.pm >> 4) ? HV : HK) + (size_t)(u.pm & 15) * 256 * 256); }
    __device__ __forceinline__ const char* b_tile(const Unit& u) const { return (const char*)((u.pm >> 4) ? V2T : K2T); }
    __device__ __forceinline__ size_t a_koff(int t) const { return (size_t)t * 128; }
};

typedef f32x4 Acc[2][2][4][2];

struct EpiInProj {
    static constexpr bool PERM = false;
    bf16_t *Q, *KV, *CQ, *CKV; float *rssq, *rsskv; const float *ropeP;
    __device__ __forceinline__ void operator()(const Acc& acc, const Unit& u, int wr, int wc, int fr, int fq) const {
        { const int ln = (int)__builtin_amdgcn_mbcnt_hi(~0u, __builtin_amdgcn_mbcnt_lo(~0u, 0u)); fr = ln & 15; fq = ln >> 4; }
        const int pn = u.pn, rowb = u.pm * 256 + wr * 64 + fr;
        if (pn < 20) {
            bf16_t* dst; int ldo; bool rope;
            if (pn < 8) { dst = Q + pn * 256; ldo = 2048; rope = true; } else { dst = KV + (pn - 8) * 256; ldo = 3072; rope = ((((pn - 8) >> 1) & 1) == 0); }
            rope = rope && (wc == 0);
#pragma unroll
            for (int ai = 0; ai < 2; ++ai)
#pragma unroll
                for (int m = 0; m < 4; ++m) {
                    const int row = rowb + ai * 128 + m * 16;
                    f32x4 v[2][2];
#pragma unroll
                    for (int bj = 0; bj < 2; ++bj) { v[bj][0] = acc[ai][bj][m][0]; v[bj][1] = acc[ai][bj][m][1]; }
                    if (rope) { const f32x4 cs = *(const f32x4*)(ropeP + (size_t)row * 32 + 4 * fq), sn = *(const f32x4*)(ropeP + (size_t)row * 32 + 16 + 4 * fq);
#pragma unroll
                        for (int bj = 0; bj < 2; ++bj) { const f32x4 x1 = v[bj][0], x2 = v[bj][1]; v[bj][0] = x1 * cs - x2 * sn; v[bj][1] = x2 * cs + x1 * sn; } }
                    bf16_t* rp = dst + (size_t)row * ldo + wc * 32 + 4 * fq;
#pragma unroll
                    for (int bj = 0; bj < 2; ++bj)
#pragma unroll
                        for (int n = 0; n < 2; ++n) *(u32x2*)(rp + bj * 128 + n * 16) = pack4(v[bj][n]);
                }
        } else {
            const bool isq = pn < 26; const int tc = isq ? pn - 20 : pn - 26;
            bf16_t* dst = isq ? CQ + tc * 256 : CKV + tc * 256; const int ldo = isq ? QR : KVR;
#pragma unroll
            for (int ai = 0; ai < 2; ++ai)
#pragma unroll
                for (int m = 0; m < 4; ++m) {
                    const int row = rowb + ai * 128 + m * 16; float ss = 0.f;
                    bf16_t* rp = dst + (size_t)row * ldo + wc * 32 + 4 * fq; unsigned char* rp8 = (unsigned char*)(isq ? CQ : CKV) + (size_t)row * ldo + tc * 256 + wc * 32 + 4 * fq;
#pragma unroll
                    for (int bj = 0; bj < 2; ++bj)
#pragma unroll
                        for (int n = 0; n < 2; ++n) { const f32x4 x = acc[ai][bj][m][n]; ss += (x[0] * x[0] + x[1] * x[1]) + (x[2] * x[2] + x[3] * x[3]);
                            if constexpr (FP8_UP) *(unsigned*)(rp8 + bj * 128 + n * 16) = pack4_fp8(x[0], x[1], x[2], x[3]); else *(u32x2*)(rp + bj * 128 + n * 16) = pack4(x); }
                    ss += __shfl_xor(ss, 16); ss += __shfl_xor(ss, 32);
                    if (fq == 0) { if (isq) rssq[(size_t)row * 24 + tc * 4 + wc] = ss; else rsskv[(size_t)row * 8 + tc * 4 + wc] = ss; }
                }
        }
    }
};
struct EpiMisc {
    static constexpr bool PERM = false;
    bf16_t* KPE; float* gates; const float* ropeM;
    __device__ __forceinline__ void operator()(const Acc& acc, const Unit& u, int wr, int wc, int fr, int fq) const {
        { const int ln = (int)__builtin_amdgcn_mbcnt_hi(~0u, __builtin_amdgcn_mbcnt_lo(~0u, 0u)); fr = ln & 15; fq = ln >> 4; }
        const int rowb = u.pm * 256 + wr * 64 + fr;
        {
#pragma unroll
            for (int ai = 0; ai < 2; ++ai)
#pragma unroll
                for (int m = 0; m < 4; ++m) {
                    const int row = rowb + ai * 128 + m * 16;
                    if (wc < 2) {
                        const int i0 = 16 * wc + 4 * fq;
                        const f32x4 cs = *(const f32x4*)(ropeM + (size_t)row * 64 + i0), sn = *(const f32x4*)(ropeM + (size_t)row * 64 + 32 + i0);
                        const f32x4 x1 = acc[ai][0][m][0], x2 = acc[ai][0][m][1];
                        *(u32x2*)(KPE + (size_t)row * 64 + i0) = pack4(x1 * cs - x2 * sn);
                        *(u32x2*)(KPE + (size_t)row * 64 + 32 + i0) = pack4(x2 * cs + x1 * sn);
                    } else {
#pragma unroll
                        for (int n = 0; n < 2; ++n) { const int gi = 32 * (wc - 2) + 16 * n + 4 * fq;
                            if (gi < 48) { const f32x4 x = acc[ai][0][m][n]; f32x4 o;
#pragma unroll
                                for (int e = 0; e < 4; ++e) o[e] = 1.0f / (1.0f + __expf(-x[e]));
                                *(f32x4*)(gates + (size_t)row * 48 + gi) = o; } }
                    }
                }
        }
    }
};

struct EpiQUp {
    static constexpr bool PERM = false;
    bf16_t* Qm; const LAS float* rf; int row0; const float* ropeM;
    __device__ __forceinline__ void operator()(const Acc& acc, const Unit& u, int wr, int wc, int fr, int fq) const {
        { const int ln = (int)__builtin_amdgcn_mbcnt_hi(~0u, __builtin_amdgcn_mbcnt_lo(~0u, 0u)); fr = ln & 15; fq = ln >> 4; }
        const int pn = u.pn, rowb = u.pm * 256 + wr * 64 + fr;
#pragma unroll
        for (int ai = 0; ai < 2; ++ai)
#pragma unroll
            for (int m = 0; m < 4; ++m) {
                const int row = rowb + ai * 128 + m * 16;
                const float r = rf[row - row0];
                bf16_t* qrow = Qm + (size_t)row * 3072;
                if (pn < 8) {
#pragma unroll
                    for (int bj = 0; bj < 2; ++bj)
#pragma unroll
                        for (int n = 0; n < 2; ++n) *(u32x2*)(qrow + (2 * pn + bj) * 192 + wc * 32 + n * 16 + 4 * fq) = pack4(acc[ai][bj][m][n] * r);
                } else {
                    const int i0 = 16 * (wc & 1) + 4 * fq;
                    const f32x4 cs = *(const f32x4*)(ropeM + (size_t)row * 64 + i0), sn = *(const f32x4*)(ropeM + (size_t)row * 64 + 32 + i0);
#pragma unroll
                    for (int bj = 0; bj < 2; ++bj) { const int head = (pn - 8) * 4 + bj * 2 + (wc >> 1);
                        const f32x4 x1 = acc[ai][bj][m][0] * r, x2 = acc[ai][bj][m][1] * r;
                        *(u32x2*)(qrow + head * 192 + 128 + i0) = pack4(x1 * cs - x2 * sn);
                        *(u32x2*)(qrow + head * 192 + 160 + i0) = pack4(x2 * cs + x1 * sn); }
                }
                asm volatile("" ::: "memory");
            }
    }
};
struct EpiKVUp {
    static constexpr bool PERM = false;
    bf16_t *KN, *VM; const LAS float* rf; int row0;
    __device__ __forceinline__ void operator()(const Acc& acc, const Unit& u, int wr, int wc, int fr, int fq) const {
        { const int ln = (int)__builtin_amdgcn_mbcnt_hi(~0u, __builtin_amdgcn_mbcnt_lo(~0u, 0u)); fr = ln & 15; fq = ln >> 4; }
        const int pn = u.pn, rowb = u.pm * 256 + wr * 64 + fr;
        bf16_t* dst = pn < 8 ? KN + pn * 256 : VM + (pn - 8) * 256;
#pragma unroll
        for (int ai = 0; ai < 2; ++ai)
#pragma unroll
            for (int m = 0; m < 4; ++m) {
                const int row = rowb + ai * 128 + m * 16;
                const float r = rf[row - row0];
                bf16_t* rp = dst + (size_t)row * 2048 + wc * 32 + 4 * fq;
#pragma unroll
                for (int bj = 0; bj < 2; ++bj)
#pragma unroll
                    for (int n = 0; n < 2; ++n) *(u32x2*)(rp + bj * 128 + n * 16) = pack4(acc[ai][bj][m][n] * r);
                asm volatile("" ::: "memory");
            }
    }
};
struct EpiCmpHid {
    static constexpr bool PERM = false;
    bf16_t *HK, *HV; const float* bias;
    __device__ __forceinline__ void operator()(const Acc& acc, const Unit& u, int wr, int wc, int fr, int fq) const {
        { const int ln = (int)__builtin_amdgcn_mbcnt_hi(~0u, __builtin_amdgcn_mbcnt_lo(~0u, 0u)); fr = ln & 15; fq = ln >> 4; }
        const int which = u.pm >> 4; bf16_t* dst = (which ? HV : HK) + (size_t)(u.pm & 15) * 256 * 256; const float* bs = bias + which * 256;
#pragma unroll
        for (int bj = 0; bj < 2; ++bj)
#pragma unroll
            for (int n = 0; n < 2; ++n) { const int col = bj * 128 + wc * 32 + n * 16 + 4 * fq; const f32x4 bv = *(const f32x4*)(bs + col);
#pragma unroll
                for (int ai = 0; ai < 2; ++ai)
#pragma unroll
                    for (int m = 0; m < 4; ++m) { const int rl = ai * 128 + wr * 64 + m * 16 + fr; const f32x4 x = acc[ai][bj][m][n] + bv; f32x4 o;
#pragma unroll
                        for (int e = 0; e < 4; ++e) { const float v = x[e], uu = 0.7978845608028654f * (v + 0.044715f * v * v * v); const float tt = __builtin_amdgcn_exp2f(uu * (2.0f * LOG2E)); o[e] = v - v / (tt + 1.0f); }
                        if (rl == 255) o = (f32x4){0.f, 0.f, 0.f, 0.f};
                        *(u32x2*)(dst + (size_t)rl * 256 + col) = pack4(o); } }
    }
};
struct EpiCmpOut {
    static constexpr bool PERM = false;
    bf16_t *KC, *VC;
    __device__ __forceinline__ void operator()(const Acc& acc, const Unit& u, int wr, int wc, int fr, int fq) const {
        { const int ln = (int)__builtin_amdgcn_mbcnt_hi(~0u, __builtin_amdgcn_mbcnt_lo(~0u, 0u)); fr = ln & 15; fq = ln >> 4; }
        bf16_t* dst = ((u.pm >> 4) ? VC : KC) + (size_t)(u.pm & 15) * 256 * 128;
#pragma unroll
        for (int ai = 0; ai < 2; ++ai)
#pragma unroll
            for (int m = 0; m < 4; ++m) { const int rl = ai * 128 + wr * 64 + m * 16 + fr;
#pragma unroll
                for (int n = 0; n < 2; ++n) *(u32x2*)(dst + (size_t)rl * 128 + wc * 32 + n * 16 + 4 * fq) = pack4(acc[ai][0][m][n]); }
    }
};
__device__ __forceinline__ void unpack8(u32x4 w, f32x4& lo, f32x4& hi) {
    lo[0] = __uint_as_float(w.x << 16); lo[1] = __uint_as_float(w.x & 0xffff0000u); lo[2] = __uint_as_float(w.y << 16); lo[3] = __uint_as_float(w.y & 0xffff0000u);
    hi[0] = __uint_as_float(w.z << 16); hi[1] = __uint_as_float(w.z & 0xffff0000u); hi[2] = __uint_as_float(w.w << 16); hi[3] = __uint_as_float(w.w & 0xffff0000u);
}
__device__ __forceinline__ u32x4 pack8f(f32x4 lo, f32x4 hi) { u32x4 w; w.x = cvtpk(lo[0], lo[1]); w.y = cvtpk(lo[2], lo[3]); w.z = cvtpk(hi[0], hi[1]); w.w = cvtpk(hi[2], hi[3]); return w; }
struct EpiY1 {
    static constexpr bool PERM = true;
    const float* x; bf16_t* y1; const float* gate;
    __device__ __forceinline__ void operator()(const Acc& acc, const Unit& u, int wr, int wc, int fr, int fq) const {
        { const int ln = (int)__builtin_amdgcn_mbcnt_hi(~0u, __builtin_amdgcn_mbcnt_lo(~0u, 0u)); fr = ln & 15; fq = ln >> 4; }
        const int rowb = u.pm * 256 + wr * 64 + fr, col0 = u.pn * 256 + wc * 32 + 8 * fq; const int b = (u.pm * 256) / S;
        const size_t yb = (((size_t)u.pm * 16 + u.pn) * 256 + (wr * 64 + fr)) * 256 + wc * 32 + 8 * fq;
        f32x4 gv[2][2];
#pragma unroll
        for (int bj = 0; bj < 2; ++bj)
#pragma unroll
            for (int n = 0; n < 2; ++n) gv[bj][n] = *(const f32x4*)(gate + (size_t)b * NADA + col0 + bj * 128 + n * 4) + 1.0f;
        f32x4 bsA[2][2][2], bsB[2][2][2];
#define Y1_LOAD(dst, am) do { _Pragma("unroll") for (int mm = 0; mm < 2; ++mm) { const int m_ = ((am) & 1) * 2 + mm; const size_t off_ = (size_t)(rowb + ((am) >> 1) * 128 + m_ * 16) * D + col0; \
            _Pragma("unroll") for (int bj = 0; bj < 2; ++bj) _Pragma("unroll") for (int n = 0; n < 2; ++n) dst[mm][bj][n] = *(const f32x4*)(x + off_ + bj * 128 + n * 4); } } while (0)
#define Y1_STORE(src, am) do { _Pragma("unroll") for (int mm = 0; mm < 2; ++mm) { const int ai_ = (am) >> 1, m_ = ((am) & 1) * 2 + mm; const size_t off_ = yb + (size_t)(ai_ * 128 + m_ * 16) * 256;        \
            _Pragma("unroll") for (int bj = 0; bj < 2; ++bj) *(u32x4*)(y1 + off_ + bj * 128) = pack8f(src[mm][bj][0] * ALPHA + gv[bj][0] * acc[ai_][bj][m_][0], src[mm][bj][1] * ALPHA + gv[bj][1] * acc[ai_][bj][m_][1]); } } while (0)
        Y1_LOAD(bsA, 0);
        Y1_LOAD(bsB, 1); asm volatile("" ::: "memory");
        Y1_STORE(bsA, 0); asm volatile("" ::: "memory");
        Y1_LOAD(bsA, 2); asm volatile("" ::: "memory");
        Y1_STORE(bsB, 1); asm volatile("" ::: "memory");
        Y1_LOAD(bsB, 3); asm volatile("" ::: "memory");
        Y1_STORE(bsA, 2); asm volatile("" ::: "memory");
        Y1_STORE(bsB, 3);
#undef Y1_LOAD
#undef Y1_STORE
    }
};
struct EpiY2 {
    static constexpr bool PERM = true;
    const bf16_t* y1; bf16_t* y2; const float* gate; const float* stats; const float* lg; const float* lb;
    __device__ __forceinline__ void operator()(const Acc& acc, const Unit& u, int wr, int wc, int fr, int fq) const {
        { const int ln = (int)__builtin_amdgcn_mbcnt_hi(~0u, __builtin_amdgcn_mbcnt_lo(~0u, 0u)); fr = ln & 15; fq = ln >> 4; }
        const int rowb = u.pm * 256 + wr * 64 + fr, col0 = u.pn * 256 + wc * 32 + 8 * fq; const int b = (u.pm * 256) / S;
        const size_t yb = (((size_t)u.pm * 16 + u.pn) * 256 + (wr * 64 + fr)) * 256 + wc * 32 + 8 * fq;
#pragma unroll
        for (int bj = 0; bj < 2; ++bj) {
            f32x4 gm[2], G[2], Bc[2];
#pragma unroll
            for (int n = 0; n < 2; ++n) { const int c = col0 + bj * 128 + n * 4; gm[n] = *(const f32x4*)(gate + (size_t)b * NADA + c) + 1.0f; G[n] = *(const f32x4*)(lg + c) * ALPHA; Bc[n] = *(const f32x4*)(lb + c) * ALPHA; }
#pragma unroll
            for (int hf = 0; hf < 2; ++hf) {
                u32x4 yv[4]; f32x2 st[4];
#pragma unroll
                for (int m = 0; m < 4; ++m) { const int row = rowb + hf * 128 + m * 16; yv[m] = *(const u32x4*)(y1 + yb + (size_t)(hf * 128 + m * 16) * 256 + bj * 128); st[m] = *(const f32x2*)(stats + (size_t)row * 2); }
#pragma unroll
                for (int m = 0; m < 4; ++m) { const int row = rowb + hf * 128 + m * 16;
                    f32x4 lo, hi; unpack8(yv[m], lo, hi); const float r = st[m][1], mr = st[m][0] * r;
                    lo = (lo * r - mr) * G[0] + Bc[0] + gm[0] * acc[hf][bj][m][0]; hi = (hi * r - mr) * G[1] + Bc[1] + gm[1] * acc[hf][bj][m][1];
                    *(u32x4*)(y2 + yb + (size_t)(hf * 128 + m * 16) * 256 + bj * 128) = pack8f(lo, hi); }
                asm volatile("" ::: "memory");
            }
            asm volatile("" ::: "memory");
        }
    }
};
struct EpiRelu2 {
    static constexpr bool PERM = true;
    bf16_t* O;
    __device__ __forceinline__ void operator()(const Acc& acc, const Unit& u, int wr, int wc, int fr, int fq) const {
        { const int ln = (int)__builtin_amdgcn_mbcnt_hi(~0u, __builtin_amdgcn_mbcnt_lo(~0u, 0u)); fr = ln & 15; fq = ln >> 4; }
        const int rl = wr * 64 + fr, kt0 = u.pn * 4 + (wc >> 1), cl = (wc & 1) * 32 + 8 * fq;
#pragma unroll
        for (int ai = 0; ai < 2; ++ai)
#pragma unroll
            for (int m = 0; m < 4; ++m) { bf16_t* rp = O + (((size_t)u.pm * (DFF / 64) + kt0) * 256 + (rl + ai * 128 + m * 16)) * 64 + cl;
#pragma unroll
                for (int bj = 0; bj < 2; ++bj) { f32x4 v0 = acc[ai][bj][m][0], v1 = acc[ai][bj][m][1];
#pragma unroll
                    for (int e = 0; e < 4; ++e) { const float a = fmaxf(v0[e], 0.f), b = fmaxf(v1[e], 0.f); v0[e] = a * a; v1[e] = b * b; }
                    u32x4 w; w.x = cvtpk(v0[0], v0[1]); w.y = cvtpk(v0[2], v0[3]); w.z = cvtpk(v1[0], v1[1]); w.w = cvtpk(v1[2], v1[3]);
                    *(u32x4*)(rp + (size_t)bj * 2 * 256 * 64) = w; } }
    }
};
}

typedef GAS unsigned gu32;
#define RLX_AGENT __ATOMIC_RELAXED, __HIP_MEMORY_SCOPE_AGENT
#define XB_TMO      128
#define XB_XCNT(j)  (256  + 64 * (j))
#define XB_XSUB(j)  (1280 + 64 * (j))
#define XB_XGEN(j)  (2304 + 64 * (j))
#define XB_TOP      3328
#define XB_TOPGEN   3392
#define XCD_BAR_WORDS 3456
#define XB_SPIN_CAP (1u << 20)

__device__ __forceinline__ unsigned xb_ld(unsigned* p)              { return __hip_atomic_load(p, __ATOMIC_RELAXED, __HIP_MEMORY_SCOPE_AGENT); }
__device__ __forceinline__ unsigned xb_add(unsigned* p, unsigned v) { return __hip_atomic_fetch_add(p, v, __ATOMIC_RELAXED, __HIP_MEMORY_SCOPE_AGENT); }
__device__ __forceinline__ unsigned xb_xcc_id() { return (unsigned)__builtin_amdgcn_s_getreg((3 << 11) | 20) & 0xFu; }
#define XB_SPIN(cond, bar) do { unsigned _sp = 0; while (cond) { __builtin_amdgcn_s_sleep(1); \
    if ((++_sp & 255u) == 0u) { if (xb_ld(&(bar)[XB_TMO])) break; if (_sp > XB_SPIN_CAP) { atomicAdd(&(bar)[XB_TMO], 1u); break; } } } } while (0)

struct XcdBarrier { unsigned* bar; unsigned x; volatile LAS unsigned* st; };

__device__ __forceinline__ XcdBarrier xcd_barrier_post(unsigned* bar, volatile LAS unsigned* st) {
    XcdBarrier b; b.bar = bar; b.x = xb_xcc_id(); b.st = st;
    if (threadIdx.x == 0) (void)xb_add(&bar[XB_XCNT(b.x)], 1u);
    return b;
}
__device__ __forceinline__ void xcd_barrier_complete(unsigned* bar, unsigned x, unsigned& nloc, unsigned& nx) {
    const unsigned G = gridDim.x * gridDim.y * gridDim.z;
    unsigned sum, cnt, mine, sp = 0u;
    for (;;) {
        sum = 0u; cnt = 0u; mine = 0u;
#pragma unroll
        for (unsigned j = 0; j < 16; ++j) { const unsigned c = xb_ld(&bar[XB_XCNT(j)]); sum += c; cnt += (c > 0u) ? 1u : 0u; mine = (j == x) ? c : mine; }
        if (sum == G) break;
        __builtin_amdgcn_s_sleep(1);
        if ((++sp & 255u) == 0u) { if (xb_ld(&bar[XB_TMO])) break; if (sp > XB_SPIN_CAP) { atomicAdd(&bar[XB_TMO], 1u); break; } }
    }
    nloc = mine > 0u ? mine : 1u; nx = cnt > 0u ? cnt : 1u;
}
__device__ __forceinline__ void xcd_barrier(const XcdBarrier& b) {
    asm volatile("s_waitcnt vmcnt(0)" ::: "memory");
    __syncthreads();
    if (threadIdx.x == 0) {
        unsigned* bar = b.bar;
        __builtin_amdgcn_s_waitcnt(0);
        unsigned nloc = b.st[0], nx = b.st[1];
        if (nloc == 0u) { xcd_barrier_complete(bar, b.x, nloc, nx); b.st[0] = nloc; b.st[1] = nx; }
        const unsigned old = xb_add(&bar[XB_XSUB(b.x)], 1u);
        const unsigned gen = old / nloc;
        if (old + 1u == (gen + 1u) * nloc) {
            __builtin_amdgcn_fence(__ATOMIC_RELEASE, "agent");
            asm volatile("s_waitcnt vmcnt(0)" ::: "memory");
            const unsigned og = xb_add(&bar[XB_TOP], 1u);
            const unsigned tg = og / nx;
            if (og + 1u == (tg + 1u) * nx) xb_add(&bar[XB_TOPGEN], 1u);
            else XB_SPIN(xb_ld(&bar[XB_TOPGEN]) == tg, bar);
            __builtin_amdgcn_fence(__ATOMIC_ACQUIRE, "agent");
            xb_add(&bar[XB_XGEN(b.x)], 1u);
            asm volatile("s_waitcnt vmcnt(0)" ::: "memory");
        } else {
            XB_SPIN(xb_ld(&bar[XB_XGEN(b.x)]) == gen, bar);
            __builtin_amdgcn_fence(__ATOMIC_ACQUIRE, "agent");
            asm volatile("s_waitcnt vmcnt(0)" ::: "memory");
        }
    }
    __syncthreads();
}

struct Frame {
    LAS unsigned char* lds;
    volatile LAS unsigned* MISC;
    int tid, lane, wave, vcu, G;
    unsigned char* ws;
    const float *x, *c, *w_ada, *b_ada, *w_in, *pos_k, *pos_v, *k1, *k2, *v1, *v2, *qn, *kvn, *w_uq, *w_ukv, *w_out, *ln1g, *ln1b, *w_ff1, *w_ff2, *ln2g, *ln2b;
    const int* positions;
    float* out;
};

__device__ __forceinline__ int pairperm64(int p) { const int blk = p >> 4, i = p & 15; return blk == 0 ? i : (blk == 1 ? 32 + i : (blk == 2 ? 16 + i : 48 + i)); }
struct MapId { __device__ __forceinline__ int operator()(int j) const { return j; } };
struct MapPad { int n; __device__ __forceinline__ int operator()(int j) const { return j < n ? j : -1; } };
struct MapWin { __device__ __forceinline__ int operator()(int j) const {
    if (j < 5120) return j;
    if (j < 6656) return 5168 + (j - 5120);
    if (j < 7168) return 6704 + (j - 6656);
    const int jj = j - 7168;
    if (jj < 64) return 7216 + pairperm64(jj);
    if (jj < 112) return 5120 + (jj - 64);
    return -1; } };
struct MapUq { __device__ __forceinline__ int operator()(int j) const {
    if (j < 2048) return (j >> 7) * 192 + (j & 127);
    const int jj = j - 2048; return (jj >> 6) * 192 + 128 + pairperm64(jj & 63); } };
struct MapUkv { __device__ __forceinline__ int operator()(int j) const {
    if (j < 2048) return (j >> 7) * 256 + (j & 127);
    const int jj = j - 2048; return (jj >> 7) * 256 + 128 + (jj & 127); } };

__device__ __forceinline__ void blk8(int r, int KBs, int& kb, int& nb) { const int g = r >> 6, a = r & 63, gk = KBs >> 3; kb = 8 * (g % gk) + (a >> 3); nb = 8 * (g / gk) + (a & 7); }
__device__ __forceinline__ void blk16(int r, int KBs, int& kb, int& nb) { const int g = r >> 8, a = r & 255, gk = KBs >> 4; kb = 16 * (g % gk) + (a >> 4); nb = 16 * (g / gk) + (a & 15); }
template <bool F8 = false, class Map>
__device__ __forceinline__ void transpose_item(const float* __restrict__ W, int Nsrc, int K, void* WTv, const float* kscale, float mul, LAS float* scr, int kb, int nb, int lane, const Map map) {
    const int k0 = 64 * kb, j0 = 32 * nb, sc = map(j0 + (lane & 31)), kh = lane >> 5;
    float v[32];
#pragma unroll
    for (int i = 0; i < 32; ++i) v[i] = sc >= 0 ? W[(size_t)(k0 + 2 * i + kh) * Nsrc + sc] : 0.f;
    if (kscale) {
#pragma unroll
        for (int i = 0; i < 32; ++i) v[i] *= kscale[k0 + 2 * i + kh];
    }
#pragma unroll
    for (int i = 0; i < 32; ++i) scr[(2 * i + kh) * 33 + (lane & 31)] = v[i];
    asm volatile("s_waitcnt lgkmcnt(0)" ::: "memory");
    if constexpr (F8) {
        unsigned char* WT = (unsigned char*)WTv; const int c = lane & 3;
#pragma unroll
        for (int jj = 0; jj < 2; ++jj) { const int n = (lane >> 2) + 16 * jj; const LAS float* s = scr + (16 * c) * 33 + n;
            u32x4 o; o.x = pack4_fp8(s[0 * 33] * mul, s[1 * 33] * mul, s[2 * 33] * mul, s[3 * 33] * mul); o.y = pack4_fp8(s[4 * 33] * mul, s[5 * 33] * mul, s[6 * 33] * mul, s[7 * 33] * mul);
            o.z = pack4_fp8(s[8 * 33] * mul, s[9 * 33] * mul, s[10 * 33] * mul, s[11 * 33] * mul); o.w = pack4_fp8(s[12 * 33] * mul, s[13 * 33] * mul, s[14 * 33] * mul, s[15 * 33] * mul);
            *(u32x4*)(WT + (size_t)(j0 + n) * K + k0 + 16 * c) = o; }
    } else {
        bf16_t* WT = (bf16_t*)WTv; const int c = lane & 7;
#pragma unroll
        for (int jj = 0; jj < 4; ++jj) { const int n = (lane >> 3) + 8 * jj; const LAS float* s = scr + (8 * c) * 33 + n;
            u32x4 o; o.x = cvtpk(s[0 * 33], s[1 * 33]); o.y = cvtpk(s[2 * 33], s[3 * 33]); o.z = cvtpk(s[4 * 33], s[5 * 33]); o.w = cvtpk(s[6 * 33], s[7 * 33]);
            *(u32x4*)(WT + (size_t)(j0 + n) * K + k0 + 8 * c) = o; }
    }
    asm volatile("s_waitcnt lgkmcnt(0)" ::: "memory");
}

__device__ const double INVM[32] = {1.0, 0.6636012376960885, 0.44036660267178046, 0.2922278225730151, 0.19392274474868576, 0.12868737343265052, 0.08539710028576561, 0.05666962144529105,
    0.03760603093086393, 0.024955408670558694, 0.016560440080994446, 0.010989528534539826, 0.007292664737217109, 0.004839421345719893, 0.003211445994752591, 0.0021311195369119653,
    0.001414213562373095, 0.0009384738703573802, 0.000622772421914596, 0.0004132725499855165, 0.0002742481756762073, 0.00018199142881462546, 0.00012076973741146504, 8.01429472224798e-05,
    5.318295896944988e-05, 3.529227739646723e-05, 2.341999896140934e-05, 1.5541540297632344e-05, 1.031338537721246e-05, 6.8439753011549275e-06, 4.5416704806078695e-06, 3.013858152139171e-06};
__device__ __forceinline__ void sincos_d(double a, float& s, float& c) {
    const double k = __builtin_rint(a * 0.63661977236758134308);
    double r = __builtin_fma(-k, 1.57079632679489655800e+00, a); r = __builtin_fma(-k, 6.12323399573676603587e-17, r);
    const double r2 = r * r;
    double sp = -7.6471637318198164759e-13; sp = sp * r2 + 1.6059043836821614599e-10; sp = sp * r2 - 2.5052108385441718775e-08; sp = sp * r2 + 2.7557319223985890653e-06;
    sp = sp * r2 - 1.9841269841269841270e-04; sp = sp * r2 + 8.3333333333333333333e-03; sp = sp * r2 - 1.6666666666666666667e-01; const double sr = r + r * r2 * sp;
    double cp = 4.7794773323873852974e-14; cp = cp * r2 - 1.1470745597729724714e-11; cp = cp * r2 + 2.0876756987868098979e-09; cp = cp * r2 - 2.7557319223985890653e-07;
    cp = cp * r2 + 2.4801587301587301587e-05; cp = cp * r2 - 1.3888888888888888889e-03; cp = cp * r2 + 4.1666666666666666667e-02; cp = cp * r2 - 0.5; const double cr = 1.0 + r2 * cp;
    const int q = (int)k & 3;
    const double ss = (q == 0) ? sr : (q == 1) ? cr : (q == 2) ? -sr : -cr;
    const double cc = (q == 0) ? cr : (q == 1) ? -sr : (q == 2) ? -cr : sr;
    s = (float)ss; c = (float)cc;
}

__device__ __forceinline__ void p0_prologue(Frame& F) {
    unsigned char* ws = F.ws;
    const int gw = F.vcu * 8 + F.wave, NGW = F.G * 8, lane = F.lane;
    {
        float* modp = (float*)(ws + WS_MODP);
        for (int it = gw; it < 96 * ADA_KCH; it += NGW) {
            const int cc = it % 96, kc = it / 96, col = 256 * cc + 4 * lane;
            f32x4 a0 = {0.f, 0.f, 0.f, 0.f}, a1 = a0, a2 = a0, a3 = a0;
            for (int k8 = 0; k8 < 4; ++k8) {
                const int kbase = 256 * kc + 64 * k8;
                float s0, s1, s2, s3;
                { const float x0 = F.c[0 * D + kbase + lane], x1 = F.c[1 * D + kbase + lane], x2 = F.c[2 * D + kbase + lane], x3 = F.c[3 * D + kbase + lane];
                  s0 = x0 / (1.f + expf(-x0)); s1 = x1 / (1.f + expf(-x1)); s2 = x2 / (1.f + expf(-x2)); s3 = x3 / (1.f + expf(-x3)); }
                const float* wp = F.w_ada + (size_t)kbase * NADA + col;
#pragma unroll 16
                for (int kk = 0; kk < 64; ++kk) { const f32x4 w = *(const f32x4*)(wp + (size_t)kk * NADA);
                    a0 += w * rdlane(s0, kk); a1 += w * rdlane(s1, kk); a2 += w * rdlane(s2, kk); a3 += w * rdlane(s3, kk); }
            }
            *(f32x4*)(modp + ((size_t)(kc * 4 + 0)) * NADA + col) = a0; *(f32x4*)(modp + ((size_t)(kc * 4 + 1)) * NADA + col) = a1;
            *(f32x4*)(modp + ((size_t)(kc * 4 + 2)) * NADA + col) = a2; *(f32x4*)(modp + ((size_t)(kc * 4 + 3)) * NADA + col) = a3;
        }
    }
    {
        LAS float* scr = (LAS float*)(F.lds + F.wave * 16384);
        constexpr int I_IN = 64 * (DINP / 32), I_UQ = (QR / 64) * (3072 / 32), I_UKV = (KVR / 64) * (4096 / 32), I_OUT = 64 * 128, I_F1 = 64 * 512, I_F2 = 256 * 128, I_C1 = 64 * 8, I_C2 = 4 * 8;
        constexpr int NITEMS = I_IN + I_UQ + I_UKV + I_OUT + I_F1 + I_F2 + 2 * I_C1 + 2 * I_C2;
        for (int it = gw; it < NITEMS; it += NGW) {
            int r = it;
            if (r < I_F1) { int kb, nb; blk16(r, 64, kb, nb); transpose_item(F.w_ff1, DFF, D, (bf16_t*)(ws + WS_WFF1T), nullptr, 1.f, scr, kb, nb, lane, MapId{}); continue; } r -= I_F1;
            if (r < I_F2) { int kb, nb; blk16(r, 256, kb, nb); transpose_item(F.w_ff2, D, DFF, (bf16_t*)(ws + WS_WFF2T), nullptr, 1.f, scr, kb, nb, lane, MapId{}); continue; } r -= I_F2;
            if (r < I_IN) { int kb, nb; blk8(r, 64, kb, nb); transpose_item<FP8_IN>(F.w_in, 7280, D, (void*)(ws + WS_WINT), nullptr, FP8_IN ? 64.f : 1.f, scr, kb, nb, lane, MapWin{}); continue; } r -= I_IN;
            if (r < I_OUT) { int kb, nb; blk16(r, 64, kb, nb); transpose_item<FP8_OUT>(F.w_out, D, D, (void*)(ws + WS_WOUTT), nullptr, FP8_OUT ? 64.f : 1.f, scr, kb, nb, lane, MapId{}); continue; } r -= I_OUT;
            if (r < I_UQ) { transpose_item<FP8_UP>(F.w_uq, 3072, QR, (void*)(ws + WS_WUQT), F.qn, FP8_UP ? 32.f : 1.f, scr, r / 96, r % 96, lane, MapUq{}); continue; } r -= I_UQ;
            if (r < I_UKV) { transpose_item<FP8_UP>(F.w_ukv, 4096, KVR, (void*)(ws + WS_WUKVT), F.kvn, FP8_UP ? 16.f : 1.f, scr, r / 128, r % 128, lane, MapUkv{}); continue; } r -= I_UKV;
            if (r < I_C1) { transpose_item(F.k1, 256, 4096, (bf16_t*)(ws + WS_K1T), nullptr, 1.f, scr, r / 8, r % 8, lane, MapId{}); continue; } r -= I_C1;
            if (r < I_C1) { transpose_item(F.v1, 256, 4096, (bf16_t*)(ws + WS_V1T), nullptr, 1.f, scr, r / 8, r % 8, lane, MapId{}); continue; } r -= I_C1;
            if (r < I_C2) { transpose_item(F.k2, 128, 256, (bf16_t*)(ws + WS_SMALL + 65536), nullptr, 1.f, scr, r / 8, r % 8, lane, MapPad{128}); continue; } r -= I_C2;
            transpose_item(F.v2, 128, 256, (bf16_t*)(ws + WS_SMALL + 196608), nullptr, 1.f, scr, r / 8, r % 8, lane, MapPad{128});
        }
    }
    {
        float* rp = (float*)(ws + WS_ROPEP); float* rm = (float*)(ws + WS_ROPEM);
        const int gt = (F.vcu * 8 + F.wave) * 64 + lane, NT = F.G * 512;
        for (int e = gt; e < T * 32; e += NT) {
            const int t = e >> 5, i = e & 31;
            const double inv = INVM[i];
            float s, c; sincos_d((double)F.positions[t] * inv, s, c);
            rm[(size_t)t * 64 + i] = c; rm[(size_t)t * 64 + 32 + i] = s;
            if ((i & 1) == 0) { rp[(size_t)t * 32 + (i >> 1)] = c; rp[(size_t)t * 32 + 16 + (i >> 1)] = s; }
        }
    }
    {
        float* bias = (float*)(ws + WS_SMALL);
        for (int it = gw; it < 128; it += NGW) {
            const int which = it >> 6, cg = it & 63; const float* pos = which ? F.pos_v : F.pos_k; const float* w1 = which ? F.v1 : F.k1;
            f32x4 a = {0.f, 0.f, 0.f, 0.f};
            for (int k = lane; k < 4096; k += 64) a += *(const f32x4*)(w1 + (size_t)k * 256 + 4 * cg) * pos[k];
#pragma unroll
            for (int e = 0; e < 4; ++e) a[e] = wave_sum(a[e]);
            if (lane == 0) *(f32x4*)(bias + which * 256 + 4 * cg) = a;
        }
    }
}

__device__ __forceinline__ void p1_modulate(Frame& F) {
    unsigned char* ws = F.ws; const float* modp = (const float*)(ws + WS_MODP); float* modf = (float*)(ws + WS_MODF);
    if (blockIdx.x < 96) {
        for (int e = F.tid; e < 1024; e += 512) { const int idx = blockIdx.x * 1024 + e, col = idx % NADA; float s = F.b_ada[col];
#pragma unroll
            for (int kc = 0; kc < ADA_KCH; ++kc) s += modp[(size_t)kc * 4 * NADA + idx];
            modf[idx] = s; }
    }
    const int w = F.vcu, b = (w * 64) / S;
    LAS float* sh = (LAS float*)F.lds; LAS float* sc = sh + D;
    for (int e = F.tid; e < 2 * D; e += 512) { float s = F.b_ada[e];
#pragma unroll
        for (int kc = 0; kc < ADA_KCH; ++kc) s += modp[((size_t)kc * 4 + b) * NADA + e];
        sh[e] = (e < D) ? s : s + 1.0f; }
    __syncthreads();
    unsigned char* H8 = ws + WS_H;
    for (int rr = 0; rr < 8; ++rr) {
        const int row = w * 64 + F.wave * 8 + rr; const f32x4* xr = (const f32x4*)(F.x + (size_t)row * D); unsigned* hr = (unsigned*)(H8 + (size_t)row * D);
        f32x4 xv[16];
#pragma unroll
        for (int i = 0; i < 16; ++i) xv[i] = xr[F.lane + 64 * i];
        __builtin_amdgcn_sched_barrier(0);
#pragma unroll
        for (int i = 0; i < 16; ++i) { const int q = F.lane + 64 * i; const f32x4 sv = *(LAS f32x4*)(sc + 4 * q), hv = *(LAS f32x4*)(sh + 4 * q); const f32x4 o = xv[i] * sv + hv;
            if constexpr (FP8_IN) *(unsigned*)(H8 + ((((size_t)(row >> 8) * 32) + (q >> 5)) * 256 + (row & 255)) * 128 + 4 * (q & 31)) = pack4_fp8(o[0], o[1], o[2], o[3]); else        ((u32x2*)((bf16_t*)(ws + WS_H) + (size_t)row * D))[q] = pack4(o); }
    }
    __syncthreads();
}

__device__ __forceinline__ size_t ytile(int row, int col) { return ((((size_t)(row >> 8) * 16) + (col >> 8)) * 256 + (row & 255)) * 256 + (col & 255); }
template <bool LN1>
__device__ __forceinline__ void ln_phase(Frame& F, const bf16_t* Yin, const float* ga, const float* be, const float* modf, float* stats, bf16_t* ob16, float* of32) {
    const int lane = F.lane, w = F.wave, c0 = 512 * w + 8 * lane;
    LAS f32x2* red = (LAS f32x2*)F.lds;
    for (int rb = F.vcu * 64; rb < T; rb += F.G * 64) {
        const int b = rb / S;
        f32x4 ca[2], cb[2];
#pragma unroll
        for (int n = 0; n < 2; ++n) {
            if (LN1) { const f32x4 sc1 = *(const f32x4*)(modf + (size_t)b * NADA + 4 * D + c0 + 4 * n) + 1.0f, sh = *(const f32x4*)(modf + (size_t)b * NADA + 3 * D + c0 + 4 * n);
                ca[n] = *(const f32x4*)(ga + c0 + 4 * n) * sc1; cb[n] = *(const f32x4*)(be + c0 + 4 * n) * sc1 + sh; }
            else { ca[n] = *(const f32x4*)(ga + c0 + 4 * n); cb[n] = *(const f32x4*)(be + c0 + 4 * n); }
        }
        u32x4 nx[8];
#pragma unroll
        for (int k = 0; k < 8; ++k) nx[k] = *(const u32x4*)(Yin + ytile(rb + k, c0));
        for (int bt = 0; bt < 8; ++bt) {
            const int r0 = rb + 8 * bt; f32x4 v[8][2];
            LAS f32x2* rd = red + (bt & 1) * 64;
#pragma unroll
            for (int k = 0; k < 8; ++k) { pg8::unpack8(nx[k], v[k][0], v[k][1]);
                float s = ((v[k][0][0] + v[k][0][1]) + (v[k][0][2] + v[k][0][3])) + ((v[k][1][0] + v[k][1][1]) + (v[k][1][2] + v[k][1][3]));
                float q = ((v[k][0][0] * v[k][0][0] + v[k][0][1] * v[k][0][1]) + (v[k][0][2] * v[k][0][2] + v[k][0][3] * v[k][0][3])) + ((v[k][1][0] * v[k][1][0] + v[k][1][1] * v[k][1][1]) + (v[k][1][2] * v[k][1][2] + v[k][1][3] * v[k][1][3]));
                s = wave_sum(s); q = wave_sum(q);
                if (lane == 0) rd[k * 8 + w] = (f32x2){s, q}; }
            if (bt < 7) {
#pragma unroll
                for (int k = 0; k < 8; ++k) nx[k] = *(const u32x4*)(Yin + ytile(r0 + 8 + k, c0));
            }
            __syncthreads();
#pragma unroll
            for (int k = 0; k < 8; ++k) {
                float s = 0.f, q = 0.f;
#pragma unroll
                for (int ww = 0; ww < 8; ++ww) { const f32x2 p = rd[k * 8 + ww]; s += p[0]; q += p[1]; }
                const float mean = s * (1.0f / D), var = fmaxf(q * (1.0f / D) - mean * mean, 0.f), rstd = 1.0f / sqrtf(var + 1e-5f);
                const size_t ro = (size_t)(r0 + k) * D + c0;
                if (LN1) { if (w == 0 && lane == 0) *(f32x2*)(stats + (size_t)(r0 + k) * 2) = (f32x2){mean, rstd};
                    const int row = r0 + k; const size_t bo = ((((size_t)(row >> 8) * (D / 64)) + (c0 >> 6)) * 256 + (row & 255)) * 64 + (c0 & 63);
                    *(u32x4*)(ob16 + bo) = pg8::pack8f((v[k][0] - mean) * rstd * ca[0] + cb[0], (v[k][1] - mean) * rstd * ca[1] + cb[1]); }
                else { *(f32x4*)(of32 + ro) = (v[k][0] - mean) * rstd * ca[0] + cb[0]; *(f32x4*)(of32 + ro + 4) = (v[k][1] - mean) * rstd * ca[1] + cb[1]; }
            }
        }
        __syncthreads();
    }
}
__device__ __forceinline__ void ln1_phase(Frame& F, const float* modf) {
    ln_phase<true>(F, (const bf16_t*)(F.ws + WS_Y1), F.ln1g, F.ln1b, modf, (float*)(F.ws + WS_STATS), (bf16_t*)(F.ws + WS_H), nullptr);
}
__device__ __forceinline__ void ln2_phase(Frame& F) {
    ln_phase<false>(F, (const bf16_t*)(F.ws + WS_H), F.ln2g, F.ln2b, nullptr, nullptr, nullptr, F.out);
}

namespace att {
constexpr int KP = 400, VP = 320;
constexpr int KBUF = 64 * KP, VBUF = 64 * VP;
constexpr int OFF_K = 0, OFF_V = 2 * KBUF, OFF_IMPG = OFF_V + 2 * VBUF, OFF_IMPL = OFF_IMPG + 16384, OFF_SELM = OFF_IMPL + 16384, OFF_UNI = OFF_SELM + 512;
static_assert(OFF_UNI + 128 <= RING_BYTES, "attention LDS map");
enum { M_CMP1 = 0, M_CMP2 = 1, M_SEL = 2, M_WIN = 3, M_MLA = 4 };

struct Stage { u32x4 k0, k1, kp, v0, v1; };
template <bool HASP, bool HASV>
__device__ __forceinline__ void stage_load(Stage& st, const bf16_t* Kg, size_t ldk, const bf16_t* Pg, const bf16_t* Vg, size_t ldv, int tid) {
    const int r0 = tid >> 4, c0 = (tid & 15) * 8;
    st.k0 = *(const u32x4*)(Kg + (size_t)r0 * ldk + c0); st.k1 = *(const u32x4*)(Kg + (size_t)(r0 + 32) * ldk + c0);
    if (HASP) st.kp = *(const u32x4*)(Pg + (size_t)(tid >> 3) * 64 + (tid & 7) * 8);
    if (HASV) { st.v0 = *(const u32x4*)(Vg + (size_t)r0 * ldv + c0); st.v1 = *(const u32x4*)(Vg + (size_t)(r0 + 32) * ldv + c0); }
}
template <bool HASP, bool HASV>
__device__ __forceinline__ void stage_store(const Stage& st, LAS unsigned char* kbuf, LAS unsigned char* vbuf, int tid) {
    const int r0 = tid >> 4, c0 = (tid & 15) * 16;
    *(LAS u32x4*)(kbuf + r0 * KP + c0) = st.k0; *(LAS u32x4*)(kbuf + (r0 + 32) * KP + c0) = st.k1;
    if (HASP) *(LAS u32x4*)(kbuf + (tid >> 3) * KP + 256 + (tid & 7) * 16) = st.kp;
    if (HASV) { *(LAS u32x4*)(vbuf + r0 * VP + c0) = st.v0; *(LAS u32x4*)(vbuf + (r0 + 32) * VP + c0) = st.v1; }
}
__device__ __forceinline__ s16x4 vtr(const LAS unsigned char* p) { return __builtin_bit_cast(s16x4, __builtin_amdgcn_ds_read_tr16_b64_v4i16((LAS s16x4*)p)); }
__device__ __forceinline__ bf16x8 pack8(const f32x16& s, int o) {
    u32x4 w; w.x = cvtpk(s[o + 0], s[o + 1]); w.y = cvtpk(s[o + 2], s[o + 3]); w.z = cvtpk(s[o + 4], s[o + 5]); w.w = cvtpk(s[o + 6], s[o + 7]); return __builtin_bit_cast(bf16x8, w);
}

template <int MODE, int NQ>
__device__ __forceinline__ void run_seq(LAS unsigned char* lds, int tid, const bf16x8 (&qf)[NQ], f32x16 (&O)[4], float& m, float& l, const float C,
                                        const bf16_t* Kg, size_t ldk, const bf16_t* Pg, const bf16_t* Vg, size_t ldv,
                                        int jlo, int jhi, unsigned long long tmask, int hiB, int loB, unsigned long long mymask, int wmax, float inv_l, int tokl, int head) {
    constexpr bool HASP = (MODE == M_MLA), HASV = (MODE != M_CMP1);
    const int lane = tid & 63, hi = lane >> 5;
    const LAS unsigned char* kb_l = lds + OFF_K + (lane & 31) * KP + hi * 16;
    const LAS unsigned char* vb_l = lds + OFF_V + (4 * hi + ((lane & 15) >> 2)) * VP + (16 * ((lane >> 4) & 1) + 4 * (lane & 3)) * 2;
    int j; unsigned long long rem = 0ull;
    if (MODE == M_SEL) { rem = tmask; j = rem ? (int)__builtin_ctzll(rem) : -1; rem &= rem - 1ull; } else { j = jlo <= jhi ? jlo : -1; }
    Stage st;
    __syncthreads();
    if (j >= 0) stage_load<HASP, HASV>(st, Kg + (size_t)j * 64 * ldk, ldk, Pg + (size_t)j * 64 * 64, Vg + (size_t)j * 64 * ldv, ldv, tid);
    int it = 0;
    while (j >= 0) {
        const int bsel = it & 1;
        stage_store<HASP, HASV>(st, lds + OFF_K + bsel * KBUF, lds + OFF_V + bsel * VBUF, tid);
        __syncthreads();
        int jn;
        if (MODE == M_SEL) { jn = rem ? (int)__builtin_ctzll(rem) : -1; rem &= rem - 1ull; } else { jn = (j + 1 <= jhi) ? j + 1 : -1; }
        if (jn >= 0) stage_load<HASP, HASV>(st, Kg + (size_t)jn * 64 * ldk, ldk, Pg + (size_t)jn * 64 * 64, Vg + (size_t)jn * 64 * ldv, ldv, tid);
        const bool lvw = (MODE == M_SEL) ? (((mymask >> j) & 1ull) != 0ull) : true;
        if (!((MODE == M_MLA && 64 * j > wmax) || (MODE == M_SEL && !__any(lvw)))) {
            const LAS unsigned char* kb = kb_l + bsel * KBUF; const LAS unsigned char* vb = vb_l + bsel * VBUF;
            f32x16 s0, s1;
#pragma unroll
            for (int r = 0; r < 16; ++r) { s0[r] = 0.f; s1[r] = 0.f; }
            {
                constexpr int KW = (NQ == 8) ? 8 : ATT_KW12;
                bf16x8 kf[KW];
#pragma unroll
                for (int i = 0; i < KW; ++i) kf[i] = *(const LAS bf16x8*)(kb + (i & 1) * 32 * KP + (i >> 1) * 32);
                __builtin_amdgcn_sched_barrier(0);
#pragma unroll
                for (int i = 0; i < 2 * NQ; ++i) {
                    if (i & 1) s1 = __builtin_amdgcn_mfma_f32_32x32x16_bf16(kf[i % KW], qf[i >> 1], s1, 0, 0, 0);
                    else s0 = __builtin_amdgcn_mfma_f32_32x32x16_bf16(kf[i % KW], qf[i >> 1], s0, 0, 0, 0);
                    if (i + KW < 2 * NQ) { kf[i % KW] = *(const LAS bf16x8*)(kb + ((i + KW) & 1) * 32 * KP + ((i + KW) >> 1) * 32); __builtin_amdgcn_sched_barrier(0); }
                }
            }
            const int hl = hiB - 64 * j - 4 * hi, ll = loB - 64 * j - 4 * hi;
            const bool lv = lvw;
            bool need = true;
            if (MODE == M_WIN || MODE == M_MLA || MODE == M_SEL) need = __any(!((hl >= 63) && (ll < 0)));
            if (need) {
                const float NEG = -__builtin_inff();
#pragma unroll
                for (int r = 0; r < 16; ++r) { const int c = (r & 3) + 8 * (r >> 2);
                    if (!(lv && c <= hl && c > ll)) s0[r] = NEG;
                    if (!(lv && c + 32 <= hl && c + 32 > ll)) s1[r] = NEG; }
            }
            if (MODE == M_CMP2) {
#pragma unroll
                for (int r = 0; r < 16; ++r) { s0[r] = __builtin_amdgcn_exp2f(s0[r] * C - m) * inv_l; s1[r] = __builtin_amdgcn_exp2f(s1[r] * C - m) * inv_l; }
                LAS float* impG = (LAS float*)(lds + OFF_IMPG); LAS float* impL = (LAS float*)(lds + OFF_IMPL);
#pragma unroll
                for (int kb2 = 0; kb2 < 2; ++kb2)
#pragma unroll
                    for (int q4 = 0; q4 < 4; ++q4) {
                        const f32x16& sv = kb2 ? s1 : s0;
                        float gs = (sv[4 * q4] + sv[4 * q4 + 1]) + (sv[4 * q4 + 2] + sv[4 * q4 + 3]), ls = sv[4 * q4 + 3];
                        gs = quad_sum(gs); ls = quad_sum(ls);
                        const int jb = 16 * j + 8 * kb2 + 2 * q4 + hi;
                        if (head == 0) { impG[tokl * 64 + jb] = gs; if (jb + 1 < 64) impL[tokl * 64 + jb + 1] = ls; }
                    }
            } else {
                float mx = s0[0];
#pragma unroll
                for (int r = 1; r < 16; ++r) mx = fmaxf(mx, s0[r]);
#pragma unroll
                for (int r = 0; r < 16; ++r) mx = fmaxf(mx, s1[r]);
                mx = xhalf_max(mx);
                if (MODE == M_SEL) mx = lv ? mx : -__builtin_inff();
                const float mn = fmaxf(m, mx * C), alpha = __builtin_amdgcn_exp2f(m - mn);
                m = mn;
                float rs = 0.f;
#pragma unroll
                for (int r = 0; r < 16; ++r) { s0[r] = __builtin_amdgcn_exp2f(s0[r] * C - mn); s1[r] = __builtin_amdgcn_exp2f(s1[r] * C - mn); rs += s0[r] + s1[r]; }
                rs = xhalf_sum(rs);
                if (MODE == M_SEL) rs = lv ? rs : 0.f;
                l = l * alpha + rs;
                if (MODE != M_CMP1) {
                    if (!__all(alpha == 1.0f)) {
#pragma unroll
                        for (int db = 0; db < 4; ++db)
#pragma unroll
                            for (int r = 0; r < 16; ++r) O[db][r] *= alpha;
                    }
                }
            }
            if (MODE != M_CMP1) {
                bf16x8 pf[4]; pf[0] = pack8(s0, 0); pf[1] = pack8(s0, 8); pf[2] = pack8(s1, 0); pf[3] = pack8(s1, 8);
                if (MODE == M_SEL) { const bf16x8 z = {0, 0, 0, 0, 0, 0, 0, 0};
#pragma unroll
                    for (int i = 0; i < 4; ++i) pf[i] = lv ? pf[i] : z; }
#pragma unroll
                for (int ks = 0; ks < 4; ++ks)
#pragma unroll
                    for (int db = 0; db < 4; ++db) {
                        const s16x4 lo = vtr(vb + (16 * ks) * VP + db * 64), hv = vtr(vb + (16 * ks + 8) * VP + db * 64);
                        const bf16x8 vf = {lo[0], lo[1], lo[2], lo[3], hv[0], hv[1], hv[2], hv[3]};
                        O[db] = __builtin_amdgcn_mfma_f32_32x32x16_bf16(vf, pf[ks], O[db], 0, 0, 0);
                    }
            }
        }
        j = jn; ++it;
    }
}

__device__ __forceinline__ void zero_o(f32x16 (&O)[4]) {
#pragma unroll
    for (int db = 0; db < 4; ++db)
#pragma unroll
        for (int r = 0; r < 16; ++r) O[db][r] = 0.f;
}

__device__ __forceinline__ void nsa_unit(Frame& F, int b, int g, int c) {
    unsigned char* ws = F.ws; LAS unsigned char* lds = F.lds;
    int tid = F.tid; asm volatile("" : "+v"(tid));
    const int lane = tid & 63, w = __builtin_amdgcn_readfirstlane(tid >> 6), ql = lane & 31, hi = lane >> 5, head = ql & 3, tokl = 8 * w + (ql >> 2);
    const int ts = 64 * c + tokl; const size_t trow = (size_t)b * S + ts; const int hg = g * 4 + head;
    const float C = 0.08838834764831845f * LOG2E;
    const bf16_t* KV = (const bf16_t*)(ws + WS_KVNSA) + (size_t)b * S * 3072 + g * 128;
    bf16_t* accb = (bf16_t*)(ws + WS_NSAACC) + trow * 2048 + hg * 128;
    bf16x8 qf[8];
    { const bf16_t* qrow = (const bf16_t*)(ws + WS_QNSA) + trow * 2048 + hg * 128 + 8 * hi;
#pragma unroll
      for (int d = 0; d < 8; ++d) qf[d] = *(const bf16x8*)(qrow + 16 * d); }
    const float* gp = (const float*)(ws + WS_GATES) + trow * 48 + hg * 3; const float gc = gp[0], gs = gp[1], gw = gp[2];
    f32x16 O[4]; float m, l;
    {
        const bf16_t* KC = (const bf16_t*)(ws + WS_KC) + (size_t)(b * 4 + g) * 256 * 128; const bf16_t* VC = (const bf16_t*)(ws + WS_VC) + (size_t)(b * 4 + g) * 256 * 128;
        const int nct = (4 * c + 2) / 64 + 1, limc = (ts - 31) >> 4;
        m = -1e30f; l = 0.f; zero_o(O);
        run_seq<M_CMP1, 8>(lds, tid, qf, O, m, l, C, KC, 128, KC, VC, 128, 0, nct - 1, 0ull, limc, -1, 0ull, 0, 0.f, tokl, head);
        const float inv_l = l > 0.f ? 1.0f / l : 0.f;
        run_seq<M_CMP2, 8>(lds, tid, qf, O, m, l, C, KC, 128, KC, VC, 128, 0, nct - 1, 0ull, limc, -1, 0ull, 0, inv_l, tokl, head);
#pragma unroll
        for (int db = 0; db < 4; ++db)
#pragma unroll
            for (int q4 = 0; q4 < 4; ++q4) { f32x4 o = {O[db][4 * q4], O[db][4 * q4 + 1], O[db][4 * q4 + 2], O[db][4 * q4 + 3]}; *(u32x2*)(accb + 32 * db + 8 * q4 + 4 * hi) = pack4(o * gc); }
    }
    __syncthreads();
    {
        LAS unsigned long long* selm = (LAS unsigned long long*)(lds + OFF_SELM); LAS unsigned long long* uni = (LAS unsigned long long*)(lds + OFF_UNI);
        const LAS float* impG = (const LAS float*)(lds + OFF_IMPG); const LAS float* impL = (const LAS float*)(lds + OFF_IMPL);
        unsigned long long wuni = 0ull;
        for (int tt = 0; tt < 8; ++tt) {
            const int tl = 8 * w + tt; unsigned long long mk;
            if (c >= 16) {
                const bool cand = (lane >= 1) && (lane <= c - 2);
                const float v = cand ? impG[tl * 64 + lane] + impL[tl * 64 + lane] : -__builtin_inff();
                int rank = 0;
                for (int i = 0; i < 64; ++i) { const float vi = rdlane(v, i); rank += ((vi > v) || (vi == v && i < lane)) ? 1 : 0; }
                mk = __ballot(cand && rank < 13) | 1ull | (1ull << c) | (1ull << (c - 1));
            } else mk = (2ull << c) - 1ull;
            if (lane == 0) selm[tl] = mk;
            wuni |= mk;
        }
        if (lane == 0) uni[w] = wuni;
    }
    __syncthreads();
    unsigned long long mymask, tmask = 0ull;
    { const LAS unsigned long long* selm = (const LAS unsigned long long*)(lds + OFF_SELM); const LAS unsigned long long* uni = (const LAS unsigned long long*)(lds + OFF_UNI);
      mymask = selm[tokl];
#pragma unroll
      for (int i = 0; i < 8; ++i) tmask |= uni[i];
      tmask &= (2ull << c) - 1ull;
      tmask = ((unsigned long long)(unsigned)__builtin_amdgcn_readfirstlane((int)(unsigned)(tmask >> 32)) << 32) | (unsigned long long)(unsigned)__builtin_amdgcn_readfirstlane((int)(unsigned)tmask); }
    m = -1e30f; l = 0.f; zero_o(O);
    run_seq<M_SEL, 8>(lds, tid, qf, O, m, l, C, KV + 2 * 512, 3072, KV, KV + 3 * 512, 3072, 0, c, tmask, ts, -1, mymask, 0, 0.f, tokl, head);
    { const float sc = l > 0.f ? gs / l : 0.f;
#pragma unroll
      for (int db = 0; db < 4; ++db)
#pragma unroll
          for (int q4 = 0; q4 < 4; ++q4) { bf16_t* p = accb + 32 * db + 8 * q4 + 4 * hi; f32x4 o = {O[db][4 * q4], O[db][4 * q4 + 1], O[db][4 * q4 + 2], O[db][4 * q4 + 3]}; const u32x2 w = *(const u32x2*)p;
              const f32x4 pr = {__uint_as_float(w.x << 16), __uint_as_float(w.x & 0xffff0000u), __uint_as_float(w.y << 16), __uint_as_float(w.y & 0xffff0000u)}; *(u32x2*)p = pack4(pr + o * sc); } }
    m = -1e30f; l = 0.f; zero_o(O);
    run_seq<M_WIN, 8>(lds, tid, qf, O, m, l, C, KV + 4 * 512, 3072, KV, KV + 5 * 512, 3072, c >= 8 ? c - 8 : 0, c, 0ull, ts, ts - 512, 0ull, 0, 0.f, tokl, head);
    { const float sc = l > 0.f ? gw / l : 0.f; unsigned char* orow = ws + WS_H + ((((trow >> 8) * 32) + hg) * 256 + (trow & 255)) * 128;
#pragma unroll
      for (int db = 0; db < 4; ++db)
#pragma unroll
          for (int q4 = 0; q4 < 4; ++q4) { const bf16_t* p = accb + 32 * db + 8 * q4 + 4 * hi; f32x4 o = {O[db][4 * q4], O[db][4 * q4 + 1], O[db][4 * q4 + 2], O[db][4 * q4 + 3]}; const u32x2 w = *(const u32x2*)p;
              const f32x4 pr = {__uint_as_float(w.x << 16), __uint_as_float(w.x & 0xffff0000u), __uint_as_float(w.y << 16), __uint_as_float(w.y & 0xffff0000u)};
              const f32x4 r = pr + o * sc;
              if constexpr (FP8_OUT) *(unsigned*)(orow + 32 * db + 8 * q4 + 4 * hi) = pack4_fp8(r[0] * 16.0f, r[1] * 16.0f, r[2] * 16.0f, r[3] * 16.0f);
              else *(u32x2*)((bf16_t*)(ws + WS_H) + trow * 4096 + hg * 128 + 32 * db + 8 * q4 + 4 * hi) = pack4(r); } }
}

__device__ __forceinline__ void mla_unit(Frame& F, int b, int hd, int qb) {
    unsigned char* ws = F.ws; LAS unsigned char* lds = F.lds;
    int tid = F.tid; asm volatile("" : "+v"(tid));
    const int lane = tid & 63, w = __builtin_amdgcn_readfirstlane(tid >> 6), ql = lane & 31, hi = lane >> 5;
    const int ts = 256 * qb + 32 * w + ql; const size_t trow = (size_t)b * S + ts;
    const float C = 0.07216878364870322f * LOG2E;
    bf16x8 qf[12];
    { const bf16_t* qrow = (const bf16_t*)(ws + WS_QMLA) + trow * 3072 + hd * 192 + 8 * hi;
#pragma unroll
      for (int d = 0; d < 12; ++d) qf[d] = *(const bf16x8*)(qrow + 16 * d); }
    const bf16_t* KN = (const bf16_t*)(ws + WS_KN) + (size_t)b * S * 2048 + hd * 128; const bf16_t* VM = (const bf16_t*)(ws + WS_VM) + (size_t)b * S * 2048 + hd * 128;
    const bf16_t* KPE = (const bf16_t*)(ws + WS_KPE) + (size_t)b * S * 64;
    f32x16 O[4]; float m = -1e30f, l = 0.f; zero_o(O);
    run_seq<M_MLA, 12>(lds, tid, qf, O, m, l, C, KN, 2048, KPE, VM, 2048, 0, 4 * qb + 3, 0ull, ts, -1, 0ull, 256 * qb + 32 * w + 31, 0.f, 0, 0);
    const float sc = l > 0.f ? (FP8_OUT ? 16.0f : 1.0f) / l : 0.f; unsigned char* orow = ws + WS_H + ((((trow >> 8) * 32) + 16 + hd) * 256 + (trow & 255)) * 128;
#pragma unroll
    for (int db = 0; db < 4; ++db)
#pragma unroll
        for (int q4 = 0; q4 < 4; ++q4) {
            if constexpr (FP8_OUT) *(unsigned*)(orow + 32 * db + 8 * q4 + 4 * hi) = pack4_fp8(O[db][4 * q4] * sc, O[db][4 * q4 + 1] * sc, O[db][4 * q4 + 2] * sc, O[db][4 * q4 + 3] * sc);
            else { f32x4 o = {O[db][4 * q4], O[db][4 * q4 + 1], O[db][4 * q4 + 2], O[db][4 * q4 + 3]}; *(u32x2*)((bf16_t*)(ws + WS_H) + trow * 4096 + 2048 + hd * 128 + 32 * db + 8 * q4 + 4 * hi) = pack4(o * sc); } }
}
}

struct Args { const void* in[23]; float* out; unsigned char* ws; int ph_lo, ph_hi; };
static_assert(sizeof(Args) == 23 * 8 + 8 + 8 + 8, "Args has no padding");

__global__ void __launch_bounds__(512, 2) fwd(Args args) {
    extern __shared__ __attribute__((aligned(16))) unsigned char lds_raw[];
    Frame F;
    F.lds = (LAS unsigned char*)lds_raw;
    F.MISC = (volatile LAS unsigned*)(F.lds + MISC_OFF);
    F.tid = threadIdx.x; F.lane = F.tid & 63; F.wave = __builtin_amdgcn_readfirstlane(F.tid >> 6);
    F.G = gridDim.x; { const int bx = blockIdx.x; F.vcu = (F.G % 8 == 0) ? (bx % 8) * (F.G / 8) + bx / 8 : bx; }
    F.ws = args.ws; F.out = args.out;
    F.x = (const float*)args.in[0]; F.c = (const float*)args.in[1]; F.positions = (const int*)args.in[2]; F.w_ada = (const float*)args.in[3]; F.b_ada = (const float*)args.in[4];
    F.w_in = (const float*)args.in[5]; F.pos_k = (const float*)args.in[6]; F.pos_v = (const float*)args.in[7]; F.k1 = (const float*)args.in[8]; F.k2 = (const float*)args.in[9];
    F.v1 = (const float*)args.in[10]; F.v2 = (const float*)args.in[11]; F.qn = (const float*)args.in[12]; F.kvn = (const float*)args.in[13]; F.w_uq = (const float*)args.in[14];
    F.w_ukv = (const float*)args.in[15]; F.w_out = (const float*)args.in[16]; F.ln1g = (const float*)args.in[17]; F.ln1b = (const float*)args.in[18]; F.w_ff1 = (const float*)args.in[19];
    F.w_ff2 = (const float*)args.in[20]; F.ln2g = (const float*)args.in[21]; F.ln2b = (const float*)args.in[22];
    unsigned char* ws = args.ws;
    for (int u = F.tid; u < (LDS_BYTES - LDSCTL_OFF) / 4; u += 512) ((LAS unsigned*)(F.lds + LDSCTL_OFF))[u] = 0u;
    __syncthreads();
    XcdBarrier bar; bar.bar = (unsigned*)(ws + WS_CTL) + CW_BAR; bar.x = 0; bar.st = nullptr;
    if (N_LAUNCHES == 1) bar = xcd_barrier_post((unsigned*)(ws + WS_CTL) + CW_BAR, F.MISC + 8);
    const int lo = args.ph_lo, hi = args.ph_hi;
#ifndef PH_MASK
#define PH_MASK 0x3ff
#endif
#ifndef REP_MASK
#define REP_MASK 0
#endif
#define NREP(k) (((REP_MASK >> (k)) & 1) ? 2 : 1)
#define IN(k) (((PH_MASK >> (k)) & 1) && lo <= (k) && (k) < hi)
#define SEAM(k) do { if (IN(k) && IN((k) + 1)) xcd_barrier(bar); } while (0)
    const float* modf = (const float*)(ws + WS_MODF);
    bf16_t* H = (bf16_t*)(ws + WS_H);

    if (IN(0)) { for (int rep = 0; rep < NREP(0); ++rep) { p0_prologue(F); __syncthreads(); } } SEAM(0);
    if (IN(1)) { for (int rep = 0; rep < NREP(1); ++rep) p1_modulate(F); } SEAM(1);
    if (IN(2)) {
        static_assert(FP8_IN && FP8_OUT, "the K-tile-blocked A images are written as e4m3"); pg8::GBlkA g{H, (const bf16_t*)(ws + WS_WINT), 128u, D * 1u, D / 2}; pg8::StaticOrder So; So.init(T, 7168, F.G, (int)blockIdx.x);
        pg8::EpiInProj E{(bf16_t*)(ws + WS_QNSA), (bf16_t*)(ws + WS_KVNSA), (bf16_t*)(ws + WS_CQ), (bf16_t*)(ws + WS_CKV), (float*)(ws + WS_RSSQ), (float*)(ws + WS_RSSKV), (const float*)(ws + WS_ROPEP)};
        pg8::gemm_phase<pg8::GBlkA, pg8::EpiInProj, pg8::StaticOrder, FP8_IN, 0x79797979, 0x7f7f7f7f, FF1_ALIGN>(F.lds, g, So, E);
    } SEAM(2);
    if (IN(3)) {
        const int m8 = F.vcu & 7, a8 = F.vcu >> 3;
        {
            pg8::GCmp1 g{(const bf16_t*)(ws + WS_KVNSA), (const bf16_t*)(ws + WS_K1T), (const bf16_t*)(ws + WS_V1T), 16u * 3072u * 2u, 4096u * 2u, 4096};
            pg8::RangeOrder So{a8, m8 == 0 ? 1 : 0, 1};
            pg8::EpiCmpHid E{(bf16_t*)(ws + WS_HIDK), (bf16_t*)(ws + WS_HIDV), (const float*)(ws + WS_SMALL)};
            pg8::gemm_phase(F.lds, g, So, E);
            asm volatile("s_waitcnt vmcnt(0)" ::: "memory"); __builtin_amdgcn_fence(__ATOMIC_RELEASE, "workgroup"); __syncthreads(); __builtin_amdgcn_fence(__ATOMIC_ACQUIRE, "agent"); asm volatile("s_waitcnt vmcnt(0)" ::: "memory");
            pg8::GCmp2 g2{(const bf16_t*)(ws + WS_HIDK), (const bf16_t*)(ws + WS_HIDV), (const bf16_t*)(ws + WS_SMALL + 65536), (const bf16_t*)(ws + WS_SMALL + 196608), 256u * 2u, 256u * 2u, 256};
            pg8::EpiCmpOut E2{(bf16_t*)(ws + WS_KC), (bf16_t*)(ws + WS_VC)};
            pg8::gemm_phase(F.lds, g2, So, E2);
        }
        {
            pg8::GBlkA g{H, (const bf16_t*)(ws + WS_WINT + (size_t)7168 * D), 128u, D * 1u, D / 2};
            pg8::RangeOrder So{2 * a8 + m8 - 1, (m8 == 1 || m8 == 2) ? 1 : 0, 1};
            pg8::EpiMisc E{(bf16_t*)(ws + WS_KPE), (float*)(ws + WS_GATES), (const float*)(ws + WS_ROPEM)};
            pg8::gemm_phase<pg8::GBlkA, pg8::EpiMisc, pg8::RangeOrder, FP8_IN, 0x79797979, 0x7f7f7f7f>(F.lds, g, So, E);
        }
        const int nq = (int)((0x0304040404020201ull >> (8 * m8)) & 0xff), pq = (int)((0x15110d0905030100ull >> (8 * m8)) & 0xff);
        const int nkv = (int)((0x0504040404040403ull >> (8 * m8)) & 0xff), pkv = (int)((0x1b17130f0b070300ull >> (8 * m8)) & 0xff);
        LAS float* rfq = (LAS float*)(F.lds + RING_BYTES + 4096); LAS float* rfkv = rfq + 512;
        {   const int row = 512 * a8 + F.tid;
            const f32x4* pq4 = (const f32x4*)((const float*)(ws + WS_RSSQ) + (size_t)row * 24); f32x4 sq = pq4[0];
#pragma unroll
            for (int i = 1; i < 6; ++i) sq += pq4[i];
            const f32x4* pk4 = (const f32x4*)((const float*)(ws + WS_RSSKV) + (size_t)row * 8); const f32x4 sk = pk4[0] + pk4[1];
            rfq[F.tid] = 1.0f / sqrtf(((sq[0] + sq[1]) + (sq[2] + sq[3])) * (1.0f / QR) + 1e-6f);
            rfkv[F.tid] = 1.0f / sqrtf(((sk[0] + sk[1]) + (sk[2] + sk[3])) * (1.0f / KVR) + 1e-6f);
            __syncthreads(); }
        {
            pg8::GLin g{(const bf16_t*)(ws + WS_CQ), (const bf16_t*)(ws + WS_WUQT), FP8_UP ? QR * 1u : QR * 2u, FP8_UP ? QR * 1u : QR * 2u, FP8_UP ? QR / 2 : QR}; pg8::RangeOrder So{24 * a8 + pq, nq, 12};
            pg8::EpiQUp E{(bf16_t*)(ws + WS_QMLA), rfq, 512 * a8, (const float*)(ws + WS_ROPEM)};
            pg8::gemm_phase<pg8::GLin, pg8::EpiQUp, pg8::RangeOrder, FP8_UP, 0x7a7a7a7a, 0x7f7f7f7f>(F.lds, g, So, E);
        }
        {
            pg8::GLin g{(const bf16_t*)(ws + WS_CKV), (const bf16_t*)(ws + WS_WUKVT), FP8_UP ? KVR * 1u : KVR * 2u, FP8_UP ? KVR * 1u : KVR * 2u, FP8_UP ? KVR / 2 : KVR}; pg8::RangeOrder So{32 * a8 + pkv, nkv, 16};
            pg8::EpiKVUp E{(bf16_t*)(ws + WS_KN), (bf16_t*)(ws + WS_VM), rfkv, 512 * a8};
            pg8::gemm_phase<pg8::GLin, pg8::EpiKVUp, pg8::RangeOrder, FP8_UP, 0x7b7b7b7b, 0x7f7f7f7f>(F.lds, g, So, E);
        }
    } SEAM(3);
    if (IN(4)) {
        if (F.wave >= 4) __builtin_amdgcn_s_setprio(1);
        for (int rep = 0; rep < NREP(11); ++rep)
        for (int item = F.vcu; item < 512; item += F.G) { const int bg = item >> 5, p = item & 31;

            for (int h2 = 0; h2 < 2; ++h2) att::nsa_unit(F, bg >> 2, bg & 3, h2 ? p : 63 - p); }
        for (int rep = 0; rep < NREP(12); ++rep)
        for (int item = F.vcu; item < 512; item += F.G) { const int bh = item >> 3, p = item & 7;

            for (int h2 = 0; h2 < 2; ++h2) att::mla_unit(F, bh >> 4, bh & 15, h2 ? p : 15 - p); }
        __builtin_amdgcn_s_setprio(0);
        __syncthreads();
    } SEAM(4);
    if (IN(5)) for (int rep = 0; rep < NREP(5); ++rep) {
        pg8::GBlkA g{H, (const bf16_t*)(ws + WS_WOUTT), 128u, D * 1u, D / 2}; pg8::StaticOrder So; So.init(T, D, F.G, (int)blockIdx.x, 4);
        pg8::EpiY1 E{F.x, (bf16_t*)(ws + WS_Y1), modf + 2 * D};
        pg8::gemm_phase<pg8::GBlkA, pg8::EpiY1, pg8::StaticOrder, FP8_OUT, 0x79797979, 0x7b7b7b7b, FF1_ALIGN>(F.lds, g, So, E);
    } SEAM(5);
    if (IN(6)) { ln1_phase(F, modf); } SEAM(6);
    if (IN(7)) for (int rep = 0; rep < NREP(7); ++rep) {
        pg8::GBlkA g{H, (const bf16_t*)(ws + WS_WFF1T), 128u, D * 2u, D}; pg8::StaticOrder So; So.init(T, DFF, F.G, (int)blockIdx.x);
        pg8::EpiRelu2 E{(bf16_t*)(ws + WS_FFH)};
        pg8::gemm_phase<pg8::GBlkA, pg8::EpiRelu2, pg8::StaticOrder, false, 0x7f7f7f7f, 0x7f7f7f7f, FF1_ALIGN>(F.lds, g, So, E);
    } SEAM(7);
    if (IN(8)) {
        pg8::GBlkA g{(const bf16_t*)(ws + WS_FFH), (const bf16_t*)(ws + WS_WFF2T), 128u, DFF * 2u, DFF}; pg8::StaticOrder So; So.init(T, D, F.G, (int)blockIdx.x, FF2_WGM);
        pg8::EpiY2 E{(const bf16_t*)(ws + WS_Y1), (bf16_t*)(ws + WS_H), modf + 5 * D, (const float*)(ws + WS_STATS), F.ln1g, F.ln1b};
        pg8::gemm_phase<pg8::GBlkA, pg8::EpiY2, pg8::StaticOrder, false, 0x7f7f7f7f, 0x7f7f7f7f, FF1_ALIGN>(F.lds, g, So, E);
    } SEAM(8);
    if (IN(9)) { ln2_phase(F); }
#undef IN
#undef SEAM
}

extern "C" void kernel_launch(void* const* d_in, const int* in_sizes, int n_in, void* d_out, int out_size, void* d_ws, size_t ws_size, hipStream_t stream) {
    static int grid = 0;
    if (grid == 0) {
        if (n_in != 23 || in_sizes[0] != T * D || out_size != T * D || ws_size < WS_END) { fprintf(stderr, "kernel_launch: unexpected shapes (n_in %d, in0 %d, out %d, ws %zu)\n", n_in, n_in > 0 ? in_sizes[0] : -1, out_size, ws_size); grid = -1; return; }
        int dev = 0, cus = 0, per_cu = 0;
        if (hipGetDevice(&dev) != hipSuccess || hipDeviceGetAttribute(&cus, hipDeviceAttributeMultiprocessorCount, dev) != hipSuccess) { grid = -1; return; }
        if (hipFuncSetAttribute((const void*)fwd, hipFuncAttributeMaxDynamicSharedMemorySize, LDS_BYTES) != hipSuccess) { fprintf(stderr, "kernel_launch: hipFuncSetAttribute failed\n"); grid = -1; return; }
        if (hipOccupancyMaxActiveBlocksPerMultiprocessor(&per_cu, (const void*)fwd, 512, LDS_BYTES) != hipSuccess || per_cu < 1) fprintf(stderr, "kernel_launch: occupancy query reports %d\n", per_cu);
        (void)hipGetLastError();
        if (cus < 256) { fprintf(stderr, "kernel_launch: %d CUs; this kernel is laid out for 256 resident workgroups\n", cus); grid = -1; return; }
        grid = 256;
    }
    if (grid < 0) return;
    if (hipMemsetAsync((char*)d_ws + WS_CTL, 0, CTL_ZERO_BYTES, stream) != hipSuccess) return;
    Args a{};
    for (int i = 0; i < 23; ++i) a.in[i] = d_in[i];
    a.out = (float*)d_out; a.ws = (unsigned char*)d_ws;
    for (int li = 0; li < N_LAUNCHES; ++li) {
        a.ph_lo = (N_LAUNCHES == 1) ? 0 : li; a.ph_hi = (N_LAUNCHES == 1) ? NPHASE : li + 1;
        hipLaunchKernelGGL(fwd, dim3(grid), dim3(512), LDS_BYTES, stream, a);
        const hipError_t le = hipPeekAtLastError();
        if (le != hipSuccess) { fprintf(stderr, "kernel_launch: launch %d failed: %s\n", li, hipGetErrorName(le)); break; }
    }
}
```
